# Optimizing an MI355X kernel written in HIP

```python
import math
import jax, jax.numpy as jnp
from jax import lax
import numpy as np

D_MODEL = 1024
BATCH = 8
SEQ = 2048
DEPTH = 2

HG_HEADS = 4
HG_DK = 128
HG_DV = 128
HG_WIDTH = HG_HEADS * HG_DK
HG_CHUNK = 64
AT_HEADS = 8
AT_KV_HEADS = 2
AT_HEAD_DIM = 64
AT_WIDTH = AT_HEADS * AT_HEAD_DIM
AT_KV_WIDTH = AT_KV_HEADS * AT_HEAD_DIM
WINDOW = 128
ATT_BLOCK = 128
N_BRANCH = 2
D_FF = 2816
N_NORMS = 6
EPS = 1e-6
IN_SIZES = (HG_WIDTH, HG_WIDTH, HG_WIDTH, HG_WIDTH,
            AT_WIDTH, AT_KV_WIDTH, AT_KV_WIDTH, D_MODEL, D_MODEL)
D_IN = sum(IN_SIZES)
IN_SPLITS = tuple(int(v) for v in np.cumsum(IN_SIZES)[:-1])

kernel_name = "hybrid_hgrn2_swa_sink_macaron"


def rms_norm(x, gain):
    xf = x.astype(jnp.float32)
    y = xf * lax.rsqrt(jnp.mean(xf * xf, axis=-1, keepdims=True) + EPS)
    return (y * gain.astype(jnp.float32)).astype(x.dtype)


def swiglu(h, w_gate, w_up, w_down):
    return (jax.nn.silu(h @ w_gate) * (h @ w_up)) @ w_down


def alibi_slopes(n_heads):
    idx = jnp.arange(1, n_heads + 1, dtype=jnp.float32)
    return jnp.exp2(-8.0 * idx / n_heads)


def hgrn2_mixer(q, f_logit, i, g_out, lb, head_gain):
    B, S, _ = q.shape
    dt = q.dtype
    nc = S // HG_CHUNK
    lb = lb.astype(jnp.float32)
    z = f_logit.astype(jnp.float32)
    log_f = jnp.logaddexp(jnp.log(lb), jnp.log1p(-lb) + jax.nn.log_sigmoid(z))
    k = (1.0 - lb) * jax.nn.sigmoid(-z)
    qf = jax.nn.silu(q.astype(jnp.float32))
    vf = i.astype(jnp.float32)

    def to_chunks(t, d):
        return t.reshape(B, nc, HG_CHUNK, HG_HEADS, d).transpose(1, 0, 3, 2, 4)

    qc, kc, vc, gc = (to_chunks(qf, HG_DK), to_chunks(k, HG_DK),
                      to_chunks(vf, HG_DV), to_chunks(log_f, HG_DK))
    causal = jnp.tril(jnp.ones((HG_CHUNK, HG_CHUNK), dtype=bool))

    def step(state, inp):
        qb, kb, vb, gb = inp
        G = jnp.cumsum(gb, axis=2)
        o_inter = jnp.einsum('bhtd,bhde->bhte', qb * jnp.exp(G), state)
        diff = G[:, :, :, None, :] - G[:, :, None, :, :]
        decay = jnp.exp(jnp.where(causal[:, :, None], diff, -jnp.inf))
        scores = jnp.einsum('bhtd,bhtsd,bhsd->bhts', qb, decay, kb)
        o = o_inter + jnp.einsum('bhts,bhse->bhte', scores, vb)
        G_last = G[:, :, -1:, :]
        new_state = (jnp.exp(G_last[:, :, 0, :])[..., None] * state
                     + jnp.einsum('bhsd,bhse->bhde', kb * jnp.exp(G_last - G), vb))
        return new_state, o

    state0 = jnp.zeros((B, HG_HEADS, HG_DK, HG_DV), jnp.float32)
    _, o = lax.scan(step, state0, (qc, kc, vc, gc))
    o = o.transpose(1, 0, 3, 2, 4).reshape(B, S, HG_HEADS, HG_DV)
    o = o * lax.rsqrt(jnp.mean(o * o, axis=-1, keepdims=True) + EPS) * head_gain.astype(jnp.float32)
    o = o.reshape(B, S, HG_WIDTH) * jax.nn.silu(g_out.astype(jnp.float32))
    return o.astype(dt)


def swa_sink_attention(q, k, v, sinks):
    B, S, _ = q.shape
    dt = q.dtype
    L = ATT_BLOCK
    nb = S // L
    G = AT_HEADS // AT_KV_HEADS
    qb = q.reshape(B, nb, L, AT_KV_HEADS, G, AT_HEAD_DIM)
    kb = k.reshape(B, nb, L, AT_KV_HEADS, AT_HEAD_DIM)
    vb = v.reshape(B, nb, L, AT_KV_HEADS, AT_HEAD_DIM)
    pad = ((0, 0), (1, 0), (0, 0), (0, 0), (0, 0))
    kk = jnp.concatenate([jnp.pad(kb[:, :-1], pad), kb], axis=2)
    vv = jnp.concatenate([jnp.pad(vb[:, :-1], pad), vb], axis=2)
    s = jnp.einsum('bnqhgd,bnkhd->bnhgqk', qb, kk).astype(jnp.float32) * (AT_HEAD_DIM ** -0.5)
    qi = jnp.arange(L)[:, None] + L
    kj = jnp.arange(2 * L)[None, :]
    dist = qi - kj
    in_window = (dist >= 0) & (dist < WINDOW)
    key_exists = (jnp.arange(nb)[:, None] * L + kj - L) >= 0
    mask = in_window[None] & key_exists[:, None, :]
    slopes = alibi_slopes(AT_HEADS).reshape(AT_KV_HEADS, G)
    s = s - slopes[:, :, None, None] * dist.astype(jnp.float32)
    s = jnp.where(mask[None, :, None, None], s, -jnp.inf)
    sink = jnp.broadcast_to(sinks.astype(jnp.float32).reshape(AT_KV_HEADS, G)[None, None, :, :, None, None],
                            s.shape[:-1] + (1,))
    p = jax.nn.softmax(jnp.concatenate([s, sink], axis=-1), axis=-1)[..., :-1]
    out = jnp.einsum('bnhgqk,bnkhd->bnqhgd', p.astype(dt), vv)
    return out.reshape(B, S, AT_WIDTH)


def setup_inputs(seed: int = 0) -> dict:
    key = jax.random.key(seed)
    ks = jax.random.split(key, 16)
    f32 = jnp.float32

    def w(k, shape, fan_in):
        return jax.random.normal(k, shape, f32) * (fan_in ** -0.5)

    return {
        "x": jax.random.normal(ks[0], (BATCH, SEQ, D_MODEL), f32),
        "norm_gains": 1.0 + 0.1 * jax.random.normal(ks[1], (DEPTH, N_NORMS, D_MODEL), f32),
        "w_ffn1_gate": w(ks[2], (DEPTH, D_MODEL, D_FF), D_MODEL),
        "w_ffn1_up": w(ks[3], (DEPTH, D_MODEL, D_FF), D_MODEL),
        "w_ffn1_down": w(ks[4], (DEPTH, D_FF, D_MODEL), D_FF),
        "w_in": w(ks[5], (DEPTH, D_MODEL, D_IN), D_MODEL),
        "hgrn_lower_bounds": jax.random.normal(ks[6], (DEPTH, HG_WIDTH), f32),
        "hgrn_head_gain": 1.0 + 0.1 * jax.random.normal(ks[7], (DEPTH, HG_DV), f32),
        "attn_sinks": 0.5 * jax.random.normal(ks[8], (DEPTH, AT_HEADS), f32),
        "w_branch_hgrn": w(ks[9], (DEPTH, HG_WIDTH, D_MODEL), HG_WIDTH),
        "w_branch_attn": w(ks[10], (DEPTH, AT_WIDTH, D_MODEL), AT_WIDTH),
        "w_out": w(ks[11], (DEPTH, D_MODEL, D_MODEL), D_MODEL),
        "w_ffn2_gate": w(ks[12], (DEPTH, D_MODEL, D_FF), D_MODEL),
        "w_ffn2_up": w(ks[13], (DEPTH, D_MODEL, D_FF), D_MODEL),
        "w_ffn2_down": w(ks[14], (DEPTH, D_FF, D_MODEL), D_FF),
    }


def reference(x, norm_gains, w_ffn1_gate, w_ffn1_up, w_ffn1_down, w_in, hgrn_lower_bounds,
              hgrn_head_gain, attn_sinks, w_branch_hgrn, w_branch_attn, w_out,
              w_ffn2_gate, w_ffn2_up, w_ffn2_down):
    lb_all = jnp.cumsum(jax.nn.softmax(hgrn_lower_bounds.astype(jnp.float32), axis=0), axis=0)
    lb_all = lb_all - lb_all[0:1]
    for l in range(DEPTH):
        gn = norm_gains[l]
        h = rms_norm(x, gn[0])
        x = x + 0.5 * rms_norm(swiglu(h, w_ffn1_gate[l], w_ffn1_up[l], w_ffn1_down[l]), gn[1])
        h = rms_norm(x, gn[2])
        proj = h @ w_in[l]
        hq, hf, hi, hg, aq, ak, av, gate_a, gate_b = jnp.split(proj, IN_SPLITS, axis=-1)
        y_hg = hgrn2_mixer(hq, hf, hi, hg, lb_all[l], hgrn_head_gain[l]) @ w_branch_hgrn[l]
        y_at = swa_sink_attention(aq, ak, av, attn_sinks[l]) @ w_branch_attn[l]
        mixed = jax.nn.sigmoid(gate_a) * y_hg + jax.nn.sigmoid(gate_b) * y_at
        x = x + rms_norm(mixed @ w_out[l], gn[3])
        h = rms_norm(x, gn[4])
        x = x + 0.5 * rms_norm(swiglu(h, w_ffn2_gate[l], w_ffn2_up[l], w_ffn2_down[l]), gn[5])
    return x
```

```cpp
#include <hip/hip_runtime.h>
#include <hip/hip_cooperative_groups.h>
#include <cstdio>
#include <cstdint>
namespace cg = cooperative_groups;
namespace pg8 {
#define PG8_LAS __attribute__((address_space(3)))
typedef unsigned short bf16_t;
typedef short bf16x8 __attribute__((ext_vector_type(8)));
typedef float f32x4 __attribute__((ext_vector_type(4)));
typedef unsigned u32x4 __attribute__((ext_vector_type(4)));
constexpr int BM = 256, BK = 64, HALF = 128, HTB = HALF * BK * 2  , STAGE_BYTES = 8 * HTB, NXCD = 8, WGM = 8;

__host__ __device__ __forceinline__ int lds_byte(int r, int c) { const int st = (r >> 4) * 2 + (c >> 5), rr = r & 15, cc = c & 31, ob = rr * 64 + cc * 2; return st * 1024 + (ob ^ (((ob >> 9) & 1) << 5)); }
__host__ __device__ __forceinline__ void stage_rc(int b, int& R, int& C) { const int st = b / 1024, sb = b % 1024, swz = sb ^ (((sb >> 9) & 1) << 5); R = (st >> 1) * 16 + swz / 64; C = (st & 1) * 32 + (swz % 64) / 2; }
__host__ __device__ __forceinline__ int perm32(int rho) { const int n = rho >> 4, i = rho & 15; return 8 * (i >> 2) + 4 * n + (i & 3); }

struct Unit { int pm, pn; };
struct Gemm { const bf16_t* A; const bf16_t* Bt; int M, N, K; };

struct StaticOrder {
    int nM, nN, nwg, G, c;
    __host__ __device__ void init(int M, int N, int G_, int c_) { nM = M / BM; nN = N / BM; nwg = nM * nN; G = G_; c = c_; }
    __host__ __device__ bool next(int i, Unit& u) const {
        const long L = (long)i * G + c; if (L >= nwg) return false;
        int wgid = (int)L; { const int q = nwg / NXCD, r = nwg % NXCD, xcd = wgid % NXCD, off = wgid / NXCD; wgid = (xcd < r ? xcd * (q + 1) : r * (q + 1) + (xcd - r) * q) + off; }
        const int nig = WGM * nN, gid = wgid / nig, fm = gid * WGM, gsz = (nM - fm) < WGM ? (nM - fm) : WGM;
        u.pm = fm + ((wgid % nig) % gsz); u.pn = (wgid % nig) / gsz; return true;
    }
    __device__ __forceinline__ void a_ready(const Unit&) const {}
    __device__ __forceinline__ void done(const Unit&) const {}
};

__device__ __forceinline__ unsigned cvt_pk_bf16(float lo, float hi) { unsigned r; asm volatile("v_cvt_pk_bf16_f32 %0, %1, %2" : "=v"(r) : "v"(lo), "v"(hi)); return r; }
typedef float f32x2 __attribute__((ext_vector_type(2)));
typedef unsigned u32x2 __attribute__((ext_vector_type(2)));
__device__ __forceinline__ float fexp(float x) { return __builtin_amdgcn_exp2f(x * 1.4426950408889634f); }
__device__ __forceinline__ float fsigmoid(float x) { return __builtin_amdgcn_rcpf(1.0f + fexp(-x)); }
__device__ __forceinline__ float fsilu(float x) { return x * fsigmoid(x); }
__device__ __forceinline__ float bflo(unsigned u) { return __uint_as_float(u << 16); }
__device__ __forceinline__ float bfhi(unsigned u) { return __uint_as_float(u & 0xffff0000u); }
__device__ __forceinline__ u32x4 pack8(const f32x4& a, const f32x4& b) { u32x4 w; w.x = cvt_pk_bf16(a[0], a[1]); w.y = cvt_pk_bf16(a[2], a[3]); w.z = cvt_pk_bf16(b[0], b[1]); w.w = cvt_pk_bf16(b[2], b[3]); return w; }

struct EpiGU {
    static constexpr bool PERM = true, AFTER_DRAIN = false;
    bf16_t* O; int ldo;
    __device__ __forceinline__ void operator()(const f32x4 (&acc)[2][2][4][2], const Unit& u, int wr, int wc, int fr, int fq) const {
        const int row0 = u.pm * BM + wr * 64 + fr, col = u.pn * 128 + wc * 32 + 8 * fq;
#pragma unroll
        for (int ai = 0; ai < 2; ++ai)
#pragma unroll
            for (int m = 0; m < 4; ++m) {
                f32x4 a0, a1;
#pragma unroll
                for (int i = 0; i < 4; ++i) { a0[i] = fsilu(acc[ai][0][m][0][i]) * acc[ai][1][m][0][i]; a1[i] = fsilu(acc[ai][0][m][1][i]) * acc[ai][1][m][1][i]; }
                *(u32x4*)(O + (size_t)(row0 + ai * HALF + m * 16) * ldo + col) = pack8(a0, a1);
            }
    }
};
struct EpiF32SS {
    static constexpr bool PERM = true, AFTER_DRAIN = false;
    float* Y; float* SS;
    __device__ __forceinline__ void operator()(const f32x4 (&acc)[2][2][4][2], const Unit& u, int wr, int wc, int fr, int fq) const {
        const int row0 = u.pm * BM + wr * 64 + fr, col = u.pn * BM + wc * 32 + 8 * fq;
#pragma unroll
        for (int ai = 0; ai < 2; ++ai)
#pragma unroll
            for (int m = 0; m < 4; ++m) {
                const int row = row0 + ai * HALF + m * 16; float s = 0.f;
#pragma unroll
                for (int bj = 0; bj < 2; ++bj) { const f32x4 v0 = acc[ai][bj][m][0], v1 = acc[ai][bj][m][1]; float* p = Y + (size_t)row * 1024 + col + bj * HALF;
                    *(f32x4*)p = v0; *(f32x4*)(p + 4) = v1;
                    s += (v0[0] * v0[0] + v0[1] * v0[1]) + (v0[2] * v0[2] + v0[3] * v0[3]) + (v1[0] * v1[0] + v1[1] * v1[1]) + (v1[2] * v1[2] + v1[3] * v1[3]); }
                s += __shfl_xor(s, 16); s += __shfl_xor(s, 32);
                if (fq == 0) SS[(size_t)row * 16 + u.pn * 4 + wc] = s;
            }
    }
};
struct EpiProj {
    static constexpr bool PERM = true, AFTER_DRAIN = false;
    bf16_t *qs, *kk, *vi, *sg, *aq, *ak, *av, *ga, *gb; float* logf; const float* lbraw; int layer;
#define PROJ_LOOP(...) _Pragma("unroll") for (int ai = 0; ai < 2; ++ai) _Pragma("unroll") for (int m = 0; m < 4; ++m) { const size_t row = (size_t)(row0 + ai * HALF + m * 16); \
        _Pragma("unroll") for (int bj = 0; bj < 2; ++bj) { f32x4 v0 = acc[ai][bj][m][0], v1 = acc[ai][bj][m][1]; const int c0 = cb + bj * HALF; __VA_ARGS__ } asm volatile("" ::: "memory"); }
    __device__ __forceinline__ void operator()(const f32x4 (&acc)[2][2][4][2], const Unit& u, int wr, int wc, int fr, int fq) const {
        const int row0 = u.pm * BM + wr * 64 + fr, pn = u.pn, cb = (pn & 1) * BM + wc * 32 + 8 * fq;
        if (pn < 2) {
            PROJ_LOOP({ _Pragma("unroll") for (int i = 0; i < 4; ++i) { v0[i] = fsilu(v0[i]); v1[i] = fsilu(v1[i]); } *(u32x4*)(qs + row * 512 + c0) = pack8(v0, v1); })
        } else if (pn < 4) {
            float lb[2][8];
#pragma unroll
            for (int bj = 0; bj < 2; ++bj)
#pragma unroll
                for (int i = 0; i < 8; ++i) { lb[bj][i] = 0.f; if (layer == 1) { const float b0 = lbraw[cb + bj * HALF + i], b1 = lbraw[512 + cb + bj * HALF + i]; lb[bj][i] = __builtin_amdgcn_rcpf(1.0f + fexp(b0 - b1)); } }
            PROJ_LOOP({ f32x4 l0, l1, k0, k1;
                _Pragma("unroll") for (int i = 0; i < 4; ++i) { const float a0 = lb[bj][i], a1 = lb[bj][4 + i];
                    const float f0 = a0 + (1.f - a0) * fsigmoid(v0[i]), f1 = a1 + (1.f - a1) * fsigmoid(v1[i]);
                    l0[i] = __logf(f0); l1[i] = __logf(f1); k0[i] = (1.f - a0) * fsigmoid(-v0[i]); k1[i] = (1.f - a1) * fsigmoid(-v1[i]); }
                float* lp = logf + row * 512 + c0; *(f32x4*)lp = l0; *(f32x4*)(lp + 4) = l1; *(u32x4*)(kk + row * 512 + c0) = pack8(k0, k1); })
        } else if (pn < 6) {
            PROJ_LOOP({ *(u32x4*)(vi + row * 512 + c0) = pack8(v0, v1); })
        } else if (pn < 8) {
            PROJ_LOOP({ _Pragma("unroll") for (int i = 0; i < 4; ++i) { v0[i] = fsilu(v0[i]); v1[i] = fsilu(v1[i]); } *(u32x4*)(sg + row * 512 + c0) = pack8(v0, v1); })
        } else if (pn < 10) {
            PROJ_LOOP({ v0 = v0 * 0.125f; v1 = v1 * 0.125f; *(u32x4*)(aq + row * 512 + c0) = pack8(v0, v1); })
        } else if (pn == 10) {
            PROJ_LOOP({ bf16_t* dst = bj == 0 ? ak : av; *(u32x4*)(dst + row * 128 + (c0 & 127)) = pack8(v0, v1); })
        } else {
            bf16_t* gdst = pn < 15 ? ga + (pn - 11) * BM : gb + (pn - 15) * BM; const int cg2 = wc * 32 + 8 * fq;
            PROJ_LOOP({ _Pragma("unroll") for (int i = 0; i < 4; ++i) { v0[i] = fsigmoid(v0[i]); v1[i] = fsigmoid(v1[i]); } (void)c0; *(u32x4*)(gdst + row * 1024 + cg2 + bj * HALF) = pack8(v0, v1); })
        }
    }
#undef PROJ_LOOP
};
template <int SECOND> struct EpiMix {
    static constexpr bool PERM = true, AFTER_DRAIN = false;
    const bf16_t* gate; float* m1; bf16_t* mixed;
    __device__ __forceinline__ void operator()(const f32x4 (&acc)[2][2][4][2], const Unit& u, int wr, int wc, int fr, int fq) const {
        const int row0 = u.pm * BM + wr * 64 + fr, col = u.pn * BM + wc * 32 + 8 * fq;
#pragma unroll
        for (int ai = 0; ai < 2; ++ai)
#pragma unroll
            for (int m = 0; m < 4; ++m)
#pragma unroll
                for (int bj = 0; bj < 2; ++bj) {
                    const size_t off = (size_t)(row0 + ai * HALF + m * 16) * 1024 + col + bj * HALF;
                    const u32x4 g = *(const u32x4*)(gate + off);
                    f32x4 v0 = acc[ai][bj][m][0], v1 = acc[ai][bj][m][1];
                    v0[0] *= bflo(g.x); v0[1] *= bfhi(g.x); v0[2] *= bflo(g.y); v0[3] *= bfhi(g.y);
                    v1[0] *= bflo(g.z); v1[1] *= bfhi(g.z); v1[2] *= bflo(g.w); v1[3] *= bfhi(g.w);
                    if (SECOND == 0) { *(f32x4*)(m1 + off) = v0; *(f32x4*)(m1 + off + 4) = v1; }
                    else { v0 = v0 + *(const f32x4*)(m1 + off); v1 = v1 + *(const f32x4*)(m1 + off + 4); *(u32x4*)(mixed + off) = pack8(v0, v1); }
                    asm volatile("" ::: "memory");
                }
    }
};
template <class Epi, class Sched, bool ALIGN_EPI = false, bool SP2 = false>
__device__ __forceinline__ void gemm_phase(PG8_LAS unsigned char* lds, const Gemm g, const Sched& S, const Epi& E) {
    int tid_ = threadIdx.x; asm volatile("" : "+v"(tid_)); const int tid = tid_, wid = __builtin_amdgcn_readfirstlane(tid >> 6), lane = tid & 63, wr = wid >> 2, wc = wid & 3, fr = lane & 15, fq = lane >> 4;
    const int K = g.K, nt = K / BK;
    unsigned voffA[2], voffB[2];
#pragma unroll
    for (int i = 0; i < 2; ++i) { int R, C; stage_rc(tid * 16 + i * 8192, R, C); const int Rb = Epi::PERM ? ((R & ~31) + perm32(R & 31)) : R;
        voffA[i] = (unsigned)(R * K + C) * 2u; voffB[i] = (unsigned)(Rb * K + C) * 2u; }
    const size_t kstep = (size_t)(BK * 2);
    const size_t hstep = (size_t)HALF * K * 2;
    const size_t tstep = 2 * hstep;
    const unsigned ldsw = (unsigned)wid * 1024u;
    const int aoff = lds_byte(wr * 64 + fr, fq * 8), boff = lds_byte(wc * 32 + fr, fq * 8);
#define PG8_SA(b, h) (((b) * 2 + (h)) * HTB)
#define PG8_SB(b, h) ((4 + (b) * 2 + (h)) * HTB)
#define PG8_STAGE(bufoff, gbase, voff) do { _Pragma("unroll") for (int _i = 0; _i < 2; ++_i) \
        __builtin_amdgcn_global_load_lds((const unsigned*)((const char*)(gbase) + (voff)[_i]), (PG8_LAS unsigned*)(lds + (bufoff) + ldsw + _i * 8192), 16, 0, 0); } while (0)
#define PG8_LDA(dst, b, h) do { _Pragma("unroll") for (int m = 0; m < 4; ++m) _Pragma("unroll") for (int k = 0; k < 2; ++k) dst[m][k] = *(const PG8_LAS bf16x8*)(lds + PG8_SA(b, h) + aoff + m * 2048 + k * 1024); } while (0)
#define PG8_LDB(dst, b, h) do { _Pragma("unroll") for (int n = 0; n < 2; ++n) _Pragma("unroll") for (int k = 0; k < 2; ++k) dst[n][k] = *(const PG8_LAS bf16x8*)(lds + PG8_SB(b, h) + boff + n * 2048 + k * 1024); } while (0)
#define PG8_MMA(ai, bj, At, Bt) do { __builtin_amdgcn_s_setprio(1); _Pragma("unroll") for (int m = 0; m < 4; ++m) _Pragma("unroll") for (int n = 0; n < 2; ++n) _Pragma("unroll") for (int k = 0; k < 2; ++k) \
        acc[ai][bj][m][n] = __builtin_amdgcn_mfma_f32_16x16x32_bf16(Bt[n][k], At[m][k], acc[ai][bj][m][n], 0, 0, 0); __builtin_amdgcn_s_setprio(0); } while (0)
#define PG8_WAIT_V(n) asm volatile("s_waitcnt vmcnt(" #n ")" ::: "memory")
#define PG8_WAIT_L(n) asm volatile("s_waitcnt lgkmcnt(" #n ")" ::: "memory")
#define PG8_BAR __builtin_amdgcn_s_barrier()
#define PG8_SCHED __builtin_amdgcn_sched_barrier(0)
    Unit cur, nxt; int ui = 0;
    if (!S.next(0, cur)) return;
    f32x4 acc[2][2][4][2];
#pragma unroll
    for (int a = 0; a < 2; ++a)
#pragma unroll
        for (int b = 0; b < 2; ++b)
#pragma unroll
            for (int m = 0; m < 4; ++m)
#pragma unroll
                for (int n = 0; n < 2; ++n) acc[a][b][m][n] = (f32x4){0.f, 0.f, 0.f, 0.f};
    bf16x8 At[4][2], B0[2][2], B1[2][2];
    const char* cA = (const char*)g.A + (size_t)cur.pm * tstep; const char* cB = (const char*)g.Bt + (size_t)cur.pn * tstep;
    S.a_ready(cur);
    if constexpr (SP2) {
        PG8_STAGE(PG8_SB(0, 0), cB, voffB); PG8_STAGE(PG8_SB(0, 1), cB + hstep, voffB); PG8_STAGE(PG8_SA(0, 0), cA, voffA); PG8_STAGE(PG8_SA(0, 1), cA + hstep, voffA);
        if (wr == 1) PG8_BAR;
        PG8_WAIT_V(2); PG8_BAR;
        PG8_STAGE(PG8_SB(1, 0), cB + kstep, voffB); PG8_STAGE(PG8_SA(1, 0), cA + kstep, voffA); PG8_STAGE(PG8_SB(1, 1), cB + hstep + kstep, voffB);
        PG8_WAIT_V(6); PG8_BAR;
    } else {
        PG8_STAGE(PG8_SB(0, 0), cB, voffB); PG8_STAGE(PG8_SA(0, 0), cA, voffA); PG8_STAGE(PG8_SB(0, 1), cB + hstep, voffB); PG8_STAGE(PG8_SA(0, 1), cA + hstep, voffA);
        if (wr == 1) PG8_BAR;
        PG8_WAIT_V(4); PG8_BAR;
        PG8_STAGE(PG8_SB(1, 0), cB + kstep, voffB); PG8_STAGE(PG8_SA(1, 0), cA + kstep, voffA); PG8_STAGE(PG8_SB(1, 1), cB + hstep + kstep, voffB);
        PG8_WAIT_V(6); PG8_BAR;
    }
    for (;;) {
        const bool has_next = S.next(ui + 1, nxt);
        const char* nA = has_next ? (const char*)g.A + (size_t)nxt.pm * tstep : cA; const char* nB = has_next ? (const char*)g.Bt + (size_t)nxt.pn * tstep : cB;
        for (int t = 0; t < nt; t += 2) {
            const bool last = (t == nt - 2);
            const char* a1 = cA + (size_t)(t + 1) * kstep;
            const char* a2 = last ? nA : cA + (size_t)(t + 2) * kstep; const char* b2 = last ? nB : cB + (size_t)(t + 2) * kstep;
            const char* a3 = a2 + kstep; const char* b3 = b2 + kstep;
            if (last && has_next) S.a_ready(nxt);
            if constexpr (SP2) {
            PG8_LDB(B0, 0, 0); PG8_LDB(B1, 0, 1); PG8_SCHED; PG8_LDA(At, 0, 0); PG8_STAGE(PG8_SA(1, 1), a1 + hstep, voffA);
            PG8_WAIT_V(8); PG8_WAIT_L(0); PG8_BAR; PG8_MMA(0, 0, At, B0); PG8_MMA(0, 1, At, B1); PG8_BAR; PG8_SCHED;
            PG8_LDA(At, 0, 1); PG8_STAGE(PG8_SB(0, 0), b2, voffB); PG8_STAGE(PG8_SB(0, 1), b2 + hstep, voffB); PG8_STAGE(PG8_SA(0, 0), a2, voffA);
            PG8_WAIT_V(8); PG8_WAIT_L(0); PG8_BAR; PG8_MMA(1, 0, At, B0); PG8_MMA(1, 1, At, B1); PG8_BAR; PG8_SCHED;
            PG8_LDB(B0, 1, 0); PG8_LDB(B1, 1, 1); PG8_SCHED; PG8_LDA(At, 1, 0); PG8_STAGE(PG8_SA(0, 1), a2 + hstep, voffA);
            PG8_WAIT_V(8); PG8_WAIT_L(0); PG8_BAR; PG8_MMA(0, 0, At, B0); PG8_MMA(0, 1, At, B1); PG8_BAR; PG8_SCHED;
            PG8_LDA(At, 1, 1); PG8_STAGE(PG8_SB(1, 0), b3, voffB); PG8_STAGE(PG8_SB(1, 1), b3 + hstep, voffB); PG8_STAGE(PG8_SA(1, 0), a3, voffA);
            PG8_WAIT_V(8); PG8_WAIT_L(0); PG8_BAR; PG8_MMA(1, 0, At, B0); PG8_MMA(1, 1, At, B1); PG8_BAR; PG8_SCHED;
            } else {
            PG8_LDB(B0, 0, 0); PG8_SCHED; PG8_LDA(At, 0, 0); PG8_STAGE(PG8_SA(1, 1), a1 + hstep, voffA);
            PG8_WAIT_L(8); PG8_BAR; PG8_WAIT_L(0); PG8_MMA(0, 0, At, B0); PG8_BAR; PG8_SCHED;
            PG8_LDB(B1, 0, 1); PG8_STAGE(PG8_SB(0, 0), b2, voffB);
            PG8_BAR; PG8_WAIT_L(0); PG8_MMA(0, 1, At, B1); PG8_BAR;
            PG8_LDA(At, 0, 1); PG8_STAGE(PG8_SA(0, 0), a2, voffA);
            PG8_BAR; PG8_WAIT_L(0); PG8_MMA(1, 0, At, B0); PG8_BAR; PG8_SCHED;
            PG8_STAGE(PG8_SB(0, 1), b2 + hstep, voffB);
            PG8_WAIT_V(6); PG8_BAR; PG8_MMA(1, 1, At, B1); PG8_BAR;
            PG8_LDB(B0, 1, 0); PG8_SCHED; PG8_LDA(At, 1, 0); PG8_STAGE(PG8_SA(0, 1), a2 + hstep, voffA);
            PG8_WAIT_L(8); PG8_BAR; PG8_WAIT_L(0); PG8_MMA(0, 0, At, B0); PG8_BAR; PG8_SCHED;
            PG8_LDB(B1, 1, 1); PG8_STAGE(PG8_SB(1, 0), b3, voffB);
            PG8_BAR; PG8_WAIT_L(0); PG8_MMA(0, 1, At, B1); PG8_BAR;
            PG8_LDA(At, 1, 1); PG8_STAGE(PG8_SA(1, 0), a3, voffA);
            PG8_BAR; PG8_WAIT_L(0); PG8_MMA(1, 0, At, B0); PG8_BAR; PG8_SCHED;
            PG8_STAGE(PG8_SB(1, 1), b3 + hstep, voffB);
            PG8_WAIT_V(6); PG8_BAR; PG8_MMA(1, 1, At, B1); PG8_BAR;
            }
        }
        if constexpr (ALIGN_EPI) { if (wr == 0) PG8_BAR; }
        if constexpr (!Epi::AFTER_DRAIN) { E(acc, cur, wr, wc, fr, fq); S.done(cur); }
        if (!has_next) break;
#pragma unroll
        for (int a = 0; a < 2; ++a)
#pragma unroll
            for (int b = 0; b < 2; ++b)
#pragma unroll
                for (int m = 0; m < 4; ++m)
#pragma unroll
                    for (int n = 0; n < 2; ++n) acc[a][b][m][n] = (f32x4){0.f, 0.f, 0.f, 0.f};
        cur = nxt; cA = nA; cB = nB; ++ui;
        if constexpr (ALIGN_EPI) { if (wr == 1) PG8_BAR; }
    }
    PG8_WAIT_V(0);
    if constexpr (!ALIGN_EPI) { if (wr == 0) PG8_BAR; }
    PG8_BAR;
    if constexpr (Epi::AFTER_DRAIN) { E.fused(acc, cur, wr, wc, fr, fq, lds, wid, lane); S.done(cur); }
#undef PG8_SA
#undef PG8_SB
#undef PG8_STAGE
#undef PG8_LDA
#undef PG8_LDB
#undef PG8_MMA
#undef PG8_WAIT_V
#undef PG8_WAIT_L
#undef PG8_BAR
#undef PG8_SCHED
}
}
#define LAS __attribute__((address_space(3)))
typedef unsigned short bf16;
typedef float f32x4 __attribute__((ext_vector_type(4)));
typedef short bf16x8 __attribute__((ext_vector_type(8)));
typedef unsigned u32x4 __attribute__((ext_vector_type(4)));
typedef unsigned u32x2 __attribute__((ext_vector_type(2)));
constexpr int NT = 16384, DM = 1024, DFF = 2816, DIN = 4864, SEQ = 2048, NWAVES = 8;
constexpr float EPS = 1e-6f;
constexpr size_t HM = 512u * 1024u;
constexpr size_t WS_SS = 2 * HM;
constexpr size_t WS_WIN = 4 * HM, WS_WBA = 23 * HM, WS_WBB = 25 * HM, WS_WOUT = 27 * HM, WS_WGU2 = 31 * HM, WS_WD2 = 53 * HM;
constexpr size_t WS_WGU1 = 64 * HM, WS_WD1 = 86 * HM;
constexpr size_t WS_KK = 64 * HM;
constexpr size_t WS_HB = 98 * HM;
constexpr size_t WS_OHG = 98 * HM, WS_OAT = 130 * HM;
constexpr size_t WS_ACT = 162 * HM;
constexpr size_t WS_Y = 338 * HM;
constexpr size_t WS_QS = 162 * HM, WS_VI = 194 * HM, WS_SG = 226 * HM, WS_AQ = 258 * HM, WS_AK = 290 * HM, WS_AV = 298 * HM, WS_LOGF = 306 * HM, WS_GA = 370 * HM, WS_GB = 434 * HM;
constexpr size_t WS_M1 = 162 * HM, WS_Z = 162 * HM, WS_MIXED = 306 * HM, WS_END = 512 * HM;
static_assert(WS_GB + 64 * HM <= WS_END && WS_Y + 128 * HM <= WS_END && WS_WD1 + 11 * HM <= WS_HB && WS_WD2 + 11 * HM <= WS_WGU1, "ws map");
constexpr int RING_BYTES = 131072, LDS_BYTES = 147456;

__device__ __forceinline__ unsigned f2bf(float f) { unsigned u = __builtin_bit_cast(unsigned, f); return (u + 0x7fffu + ((u >> 16) & 1u)) >> 16; }
__device__ __forceinline__ unsigned pk2(float lo, float hi) { return pg8::cvt_pk_bf16(lo, hi); }
__device__ __forceinline__ float bflo(unsigned u) { return __uint_as_float(u << 16); }
__device__ __forceinline__ float bfhi(unsigned u) { return __uint_as_float(u & 0xffff0000u); }
__device__ __forceinline__ float fexp(float x) { return __builtin_amdgcn_exp2f(x * 1.4426950408889634f); }
__device__ __forceinline__ float wave_sum(float v) {
#pragma unroll
    for (int o = 1; o < 64; o <<= 1) v += __shfl_xor(v, o);
    return v;
}
#define MFMA16(a, b, c) __builtin_amdgcn_mfma_f32_16x16x32_bf16((a), (b), (c), 0, 0, 0)

__device__ __forceinline__ void transpose_item(const float* W, int K, int N, bf16* WT, int gu, LAS float* scr, int item, int lane) {
    const int nblk = N / 32, kb = item / nblk, nb = item % nblk, k0 = 64 * kb, n0 = 32 * nb;
    const int r0 = gu ? (256 * (n0 >> 7) + (n0 & 127) + 128 * (gu - 1)) : n0;
#pragma unroll 8
    for (int i = 0; i < 32; ++i) { const int kk = 2 * i + (lane >> 5); scr[kk * 33 + (lane & 31)] = W[(size_t)(k0 + kk) * N + n0 + (lane & 31)]; }
    asm volatile("s_waitcnt lgkmcnt(0)" ::: "memory");
    const int c = lane & 7;
#pragma unroll
    for (int j = 0; j < 4; ++j) { const int n = (lane >> 3) + 8 * j; const LAS float* s = scr + (8 * c) * 33 + n;
        u32x4 o; o.x = pk2(s[0 * 33], s[1 * 33]); o.y = pk2(s[2 * 33], s[3 * 33]); o.z = pk2(s[4 * 33], s[5 * 33]); o.w = pk2(s[6 * 33], s[7 * 33]);
        *(u32x4*)(WT + (size_t)(r0 + n) * K + k0 + 8 * c) = o; }
    asm volatile("s_waitcnt lgkmcnt(0)" ::: "memory");
}
struct Inputs { const float *x, *gains, *g1, *u1, *d1, *win, *lbraw, *hgain, *sinks, *wba, *wbb, *wout, *g2, *u2, *d2; };
__device__ __forceinline__ void convert_layer(const Inputs& I, int l, unsigned char* ws, LAS unsigned char* lds, int gw, int ngw, int wave, int lane) {
    LAS float* scr = (LAS float*)(lds + wave * 16384);
    constexpr int I_G = 16 * 88, I_D = 44 * 32, I_IN = 16 * 152, I_B = 8 * 32, I_O = 16 * 32;
    constexpr int NITEMS = 6 * I_G + I_IN + 2 * I_B + I_O;
    const size_t oF = (size_t)l * DM * DFF, oIn = (size_t)l * DM * DIN, oB = (size_t)l * 512 * DM, oO = (size_t)l * DM * DM;
    for (int it = gw; it < NITEMS; it += ngw) {
        int r = it;
        if (r < I_G) { transpose_item(I.g1 + oF, DM, DFF, (bf16*)(ws + WS_WGU1), 1, scr, r, lane); continue; } r -= I_G;
        if (r < I_G) { transpose_item(I.u1 + oF, DM, DFF, (bf16*)(ws + WS_WGU1), 2, scr, r, lane); continue; } r -= I_G;
        if (r < I_D) { transpose_item(I.d1 + oF, DFF, DM, (bf16*)(ws + WS_WD1), 0, scr, r, lane); continue; } r -= I_D;
        if (r < I_IN) { transpose_item(I.win + oIn, DM, DIN, (bf16*)(ws + WS_WIN), 0, scr, r, lane); continue; } r -= I_IN;
        if (r < I_B) { transpose_item(I.wba + oB, 512, DM, (bf16*)(ws + WS_WBA), 0, scr, r, lane); continue; } r -= I_B;
        if (r < I_B) { transpose_item(I.wbb + oB, 512, DM, (bf16*)(ws + WS_WBB), 0, scr, r, lane); continue; } r -= I_B;
        if (r < I_O) { transpose_item(I.wout + oO, DM, DM, (bf16*)(ws + WS_WOUT), 0, scr, r, lane); continue; } r -= I_O;
        if (r < I_G) { transpose_item(I.g2 + oF, DM, DFF, (bf16*)(ws + WS_WGU2), 1, scr, r, lane); continue; } r -= I_G;
        if (r < I_G) { transpose_item(I.u2 + oF, DM, DFF, (bf16*)(ws + WS_WGU2), 2, scr, r, lane); continue; } r -= I_G;
        transpose_item(I.d2 + oF, DFF, DM, (bf16*)(ws + WS_WD2), 0, scr, r, lane);
    }
}
__device__ __forceinline__ void row_phase(const float* xsrc, float* xdst, const float* y, const float* ss, const float* gpost, float coef, const float* gpre, bf16* hb, int gw, int ngw, int lane) {
    for (int m = gw; m < NT; m += ngw) {
        const f32x4* xr = (const f32x4*)(xsrc + (size_t)m * DM) + lane;
        f32x4 v[4];
#pragma unroll
        for (int j = 0; j < 4; ++j) v[j] = xr[64 * j];
        if (y) {
            float s = ss[(size_t)m * 16 + (lane & 15)];
            s += __shfl_xor(s, 1); s += __shfl_xor(s, 2); s += __shfl_xor(s, 4); s += __shfl_xor(s, 8);
            const float r = coef * __builtin_amdgcn_rsqf(s * (1.f / DM) + EPS);
            const f32x4* yr = (const f32x4*)(y + (size_t)m * DM) + lane; const f32x4* gp = (const f32x4*)gpost + lane;
#pragma unroll
            for (int j = 0; j < 4; ++j) v[j] = v[j] + yr[64 * j] * gp[64 * j] * r;
        }
        if (xdst) { f32x4* xo = (f32x4*)(xdst + (size_t)m * DM) + lane;
#pragma unroll
            for (int j = 0; j < 4; ++j) xo[64 * j] = v[j]; }
        if (hb) {
            float s2 = 0.f;
#pragma unroll
            for (int j = 0; j < 4; ++j) s2 += (v[j].x * v[j].x + v[j].y * v[j].y) + (v[j].z * v[j].z + v[j].w * v[j].w);
            const float r2 = __builtin_amdgcn_rsqf(wave_sum(s2) * (1.f / DM) + EPS);
            const f32x4* gq = (const f32x4*)gpre + lane; u32x2* o8 = (u32x2*)(hb + (size_t)m * DM) + lane;
#pragma unroll
            for (int j = 0; j < 4; ++j) { const f32x4 g = gq[64 * j]; u32x2 o; o.x = pk2(v[j].x * r2 * g.x, v[j].y * r2 * g.y); o.y = pk2(v[j].z * r2 * g.z, v[j].w * r2 * g.w); o8[64 * j] = o; }
        }
    }
}

__device__ __forceinline__ void hgrn_seq(LAS unsigned char* lds, int bh, const bf16* qs, const float* logf, const bf16* kk, const bf16* vi, const bf16* sg, const float* hgain, bf16* ohg, int tid) {
    const int lane = tid & 63, w = __builtin_amdgcn_readfirstlane(tid >> 6), fr = lane & 15, fq = lane >> 4;
    const int b = bh >> 2, h = bh & 3;
    constexpr int L_Q = 0, L_K = 17408, L_KT = 34816, L_VT = 53248, L_ST = 71680, L_P = 106496, L_WT = 115712, L_VEC = 119808, L_SSX = 121344;
    static_assert(L_SSX + 512 <= RING_BYTES, "hgrn lds");
    const int cgp = tid & 15, rg = tid >> 4;
    f32x4 S[8];
#pragma unroll
    for (int j = 0; j < 8; ++j) S[j] = (f32x4){0.f, 0.f, 0.f, 0.f};
    const size_t rowb = (size_t)b * SEQ; const int colg = h * 128 + 8 * cgp;
    f32x4 lf[2][2]; u32x4 qv[2], kv[2], vv[2];
#define HG_LOAD(c) do { _Pragma("unroll") for (int rr = 0; rr < 2; ++rr) { const size_t off = (rowb + 64 * (c) + 2 * rg + rr) * 512 + colg; \
        lf[rr][0] = *(const f32x4*)(logf + off); lf[rr][1] = *(const f32x4*)(logf + off + 4); qv[rr] = *(const u32x4*)(qs + off); kv[rr] = *(const u32x4*)(kk + off); vv[rr] = *(const u32x4*)(vi + off); } } while (0)
    HG_LOAD(0);
#pragma nounroll
    for (int c = 0; c < 32; ++c) {
        float G0[8], G1[8], pin[8];
#pragma unroll
        for (int j = 0; j < 8; ++j) { G0[j] = lf[0][j >> 2][j & 3]; G1[j] = G0[j] + lf[1][j >> 2][j & 3];
            float x = G1[j]; float y = __shfl_up(x, 16); if (lane >= 16) x += y; y = __shfl_up(x, 32); if (lane >= 32) x += y;
            pin[j] = x - G1[j];
            if (lane >= 48) *(LAS float*)(lds + L_WT + (w * 128 + 8 * cgp + j) * 4) = x; }
        float qf[2][8], kf[2][8]; unsigned vb[2][4];
#pragma unroll
        for (int rr = 0; rr < 2; ++rr) {
            qf[rr][0] = bflo(qv[rr].x); qf[rr][1] = bfhi(qv[rr].x); qf[rr][2] = bflo(qv[rr].y); qf[rr][3] = bfhi(qv[rr].y); qf[rr][4] = bflo(qv[rr].z); qf[rr][5] = bfhi(qv[rr].z); qf[rr][6] = bflo(qv[rr].w); qf[rr][7] = bfhi(qv[rr].w);
            kf[rr][0] = bflo(kv[rr].x); kf[rr][1] = bfhi(kv[rr].x); kf[rr][2] = bflo(kv[rr].y); kf[rr][3] = bfhi(kv[rr].y); kf[rr][4] = bflo(kv[rr].z); kf[rr][5] = bfhi(kv[rr].z); kf[rr][6] = bflo(kv[rr].w); kf[rr][7] = bfhi(kv[rr].w);
            vb[rr][0] = vv[rr].x; vb[rr][1] = vv[rr].y; vb[rr][2] = vv[rr].z; vb[rr][3] = vv[rr].w;
        }
        __syncthreads();
        float pre[8], gref[8], glast[8];
#pragma unroll
        for (int j = 0; j < 8; ++j) { pre[j] = 0.f; gref[j] = 0.f; glast[j] = 0.f; }
#pragma unroll
        for (int w2 = 0; w2 < 8; ++w2) { const f32x4 a = *(const LAS f32x4*)(lds + L_WT + (w2 * 128 + 8 * cgp) * 4), bq = *(const LAS f32x4*)(lds + L_WT + (w2 * 128 + 8 * cgp + 4) * 4);
#pragma unroll
            for (int j = 0; j < 8; ++j) { const float t = j < 4 ? a[j & 3] : bq[j & 3]; if (w2 < w) pre[j] += t; if (w2 < 4) gref[j] += t; glast[j] += t; } }
        {
            float qt[2][8], kt[2][8];
#pragma unroll
            for (int j = 0; j < 8; ++j) {
                const float g0 = pre[j] + pin[j] + G0[j], g1 = pre[j] + pin[j] + G1[j];
                const float d0 = fminf(fmaxf(g0 - gref[j], -60.f), 60.f), d1 = fminf(fmaxf(g1 - gref[j], -60.f), 60.f);
                qt[0][j] = qf[0][j] * fexp(d0); kt[0][j] = kf[0][j] * fexp(-d0); qt[1][j] = qf[1][j] * fexp(d1); kt[1][j] = kf[1][j] * fexp(-d1);
            }
#pragma unroll
            for (int rr = 0; rr < 2; ++rr) {
                u32x4 qo, ko; qo.x = pk2(qt[rr][0], qt[rr][1]); qo.y = pk2(qt[rr][2], qt[rr][3]); qo.z = pk2(qt[rr][4], qt[rr][5]); qo.w = pk2(qt[rr][6], qt[rr][7]);
                ko.x = pk2(kt[rr][0], kt[rr][1]); ko.y = pk2(kt[rr][2], kt[rr][3]); ko.z = pk2(kt[rr][4], kt[rr][5]); ko.w = pk2(kt[rr][6], kt[rr][7]);
                *(LAS u32x4*)(lds + L_Q + (2 * rg + rr) * 272 + cgp * 16) = qo; *(LAS u32x4*)(lds + L_K + (2 * rg + rr) * 272 + cgp * 16) = ko;
            }
#pragma unroll
            for (int j = 0; j < 8; ++j) {
                *(LAS unsigned*)(lds + L_KT + (8 * cgp + j) * 144 + rg * 4) = pk2(kt[0][j], kt[1][j]);
                const unsigned v0 = (j & 1) ? (vb[0][j >> 1] >> 16) : (vb[0][j >> 1] & 0xffffu), v1 = (j & 1) ? (vb[1][j >> 1] >> 16) : (vb[1][j >> 1] & 0xffffu);
                *(LAS unsigned*)(lds + L_VT + (8 * cgp + j) * 144 + rg * 4) = v0 | (v1 << 16);
            }
            if (rg == 0) {
#pragma unroll
                for (int j = 0; j < 8; ++j) { LAS float* vp = (LAS float*)(lds + L_VEC) + 8 * cgp + j;
                    vp[0] = fexp(fmaxf(gref[j], -80.f)); vp[128] = fexp(fmaxf(glast[j], -80.f)); vp[256] = fexp(fmaxf(glast[j] - gref[j], -80.f)); }
            }
        }
        __syncthreads();
        if (c + 1 < 32) HG_LOAD(c + 1);
        {
            const f32x4 em = *(const LAS f32x4*)(lds + L_VEC + (16 * w + 4 * fq) * 4);
#pragma unroll
            for (int j = 0; j < 8; ++j) { const f32x4 v = S[j] * em; u32x2 o; o.x = pk2(v[0], v[1]); o.y = pk2(v[2], v[3]);
                *(LAS u32x2*)(lds + L_ST + (16 * j + fr) * 272 + (16 * w + 4 * fq) * 2) = o; }
#pragma unroll
            for (int x = 0; x < 2; ++x) {
                const int lin = 2 * w + x, ti = lin >> 2, si = lin & 3;
                f32x4 acc = (f32x4){0.f, 0.f, 0.f, 0.f};
#pragma unroll
                for (int ks = 0; ks < 4; ++ks) { const bf16x8 a = *(const LAS bf16x8*)(lds + L_K + (16 * si + fr) * 272 + ks * 64 + fq * 16), bq = *(const LAS bf16x8*)(lds + L_Q + (16 * ti + fr) * 272 + ks * 64 + fq * 16);
                    acc = MFMA16(a, bq, acc); }
                const int t = 16 * ti + fr, s0 = 16 * si + 4 * fq;
                float p[4];
#pragma unroll
                for (int i = 0; i < 4; ++i) p[i] = (s0 + i <= t) ? acc[i] : 0.f;
                u32x2 o; o.x = pk2(p[0], p[1]); o.y = pk2(p[2], p[3]);
                *(LAS u32x2*)(lds + L_P + t * 144 + s0 * 2) = o;
            }
        }
        __syncthreads();
        const int ti = w >> 1, eh = w & 1;
        f32x4 o[4]; float ssq = 0.f;
        {
            bf16x8 bq[4], bp[2];
#pragma unroll
            for (int ks = 0; ks < 4; ++ks) bq[ks] = *(const LAS bf16x8*)(lds + L_Q + (16 * ti + fr) * 272 + ks * 64 + fq * 16);
#pragma unroll
            for (int ks = 0; ks < 2; ++ks) bp[ks] = *(const LAS bf16x8*)(lds + L_P + (16 * ti + fr) * 144 + ks * 64 + fq * 16);
#pragma unroll
            for (int jj = 0; jj < 4; ++jj) { const int ej = 4 * eh + jj; f32x4 acc = (f32x4){0.f, 0.f, 0.f, 0.f};
#pragma unroll
                for (int ks = 0; ks < 4; ++ks) { const bf16x8 a = *(const LAS bf16x8*)(lds + L_ST + (16 * ej + fr) * 272 + ks * 64 + fq * 16); acc = MFMA16(a, bq[ks], acc); }
#pragma unroll
                for (int ks = 0; ks < 2; ++ks) { const bf16x8 a = *(const LAS bf16x8*)(lds + L_VT + (16 * ej + fr) * 144 + ks * 64 + fq * 16); acc = MFMA16(a, bp[ks], acc); }
                o[jj] = acc; ssq += (acc[0] * acc[0] + acc[1] * acc[1]) + (acc[2] * acc[2] + acc[3] * acc[3]); }
            ssq += __shfl_xor(ssq, 16); ssq += __shfl_xor(ssq, 32);
            if (fq == 0) *(LAS float*)(lds + L_SSX + ((16 * ti + fr) * 2 + eh) * 4) = ssq;
        }
        const size_t orow = (rowb + 64 * c + 16 * ti + fr) * 512 + h * 128 + 64 * eh + 4 * fq;
        u32x2 sgv[4];
#pragma unroll
        for (int jj = 0; jj < 4; ++jj) sgv[jj] = *(const u32x2*)(sg + orow + 16 * jj);
        {
            const f32x4 aL = *(const LAS f32x4*)(lds + L_VEC + (128 + 16 * w + 4 * fq) * 4), cf = *(const LAS f32x4*)(lds + L_VEC + (256 + 16 * w + 4 * fq) * 4);
            bf16x8 ak[2];
#pragma unroll
            for (int ks = 0; ks < 2; ++ks) ak[ks] = *(const LAS bf16x8*)(lds + L_KT + (16 * w + fr) * 144 + ks * 64 + fq * 16);
#pragma unroll
            for (int j = 0; j < 8; ++j) { f32x4 tmp = (f32x4){0.f, 0.f, 0.f, 0.f};
#pragma unroll
                for (int ks = 0; ks < 2; ++ks) { const bf16x8 bv = *(const LAS bf16x8*)(lds + L_VT + (16 * j + fr) * 144 + ks * 64 + fq * 16); tmp = MFMA16(ak[ks], bv, tmp); }
                S[j] = aL * S[j] + cf * tmp; }
        }
        __syncthreads();
        {
            const float tot = *(const LAS float*)(lds + L_SSX + ((16 * ti + fr) * 2) * 4) + *(const LAS float*)(lds + L_SSX + ((16 * ti + fr) * 2 + 1) * 4);
            const float rn = __builtin_amdgcn_rsqf(tot * (1.f / 128.f) + EPS);
#pragma unroll
            for (int jj = 0; jj < 4; ++jj) { const f32x4 hg = *(const f32x4*)(hgain + 64 * eh + 16 * jj + 4 * fq);
                u32x2 ov; ov.x = pk2(o[jj][0] * rn * hg[0] * bflo(sgv[jj].x), o[jj][1] * rn * hg[1] * bfhi(sgv[jj].x)); ov.y = pk2(o[jj][2] * rn * hg[2] * bflo(sgv[jj].y), o[jj][3] * rn * hg[3] * bfhi(sgv[jj].y));
                *(u32x2*)(ohg + orow + 16 * jj) = ov; }
        }
    }
#undef HG_LOAD
}

__device__ __forceinline__ void attn_units(LAS unsigned char* lds, int first, int stride, const bf16* aq, const bf16* ak, const bf16* av, const float* sinks, bf16* oat, int tid) {
    const int lane = tid & 63, w = __builtin_amdgcn_readfirstlane(tid >> 6), fr = lane & 15, fq = lane >> 4;
    constexpr int L_AK = 0, L_AVT = 36864;
    for (int unit = first; unit < 1024; unit += stride) {
        const int nb = unit & 15, hq = (unit >> 4) & 7, b = unit >> 7, kvh = hq >> 2, t0 = nb * 128;
        const size_t rowb = (size_t)b * SEQ;
#pragma unroll
        for (int i = 0; i < 4; ++i) {
            const int p = tid + 512 * i, key = p >> 3, dc = p & 7, kpos = t0 - 128 + key;
            u32x4 kx = (u32x4){0u, 0u, 0u, 0u}, vx = kx;
            if (kpos >= 0) { const size_t off = (rowb + kpos) * 128 + kvh * 64 + dc * 8; kx = *(const u32x4*)(ak + off); vx = *(const u32x4*)(av + off); }
            *(LAS u32x4*)(lds + L_AK + key * 144 + dc * 16) = kx;
            const unsigned vw[4] = {vx.x, vx.y, vx.z, vx.w};
#pragma unroll
            for (int j = 0; j < 8; ++j) *(LAS unsigned short*)(lds + L_AVT + (dc * 8 + j) * 528 + key * 2) = (unsigned short)((j & 1) ? (vw[j >> 1] >> 16) : (vw[j >> 1] & 0xffffu));
        }
        const int q = 16 * w + fr;
        bf16x8 qf[2];
#pragma unroll
        for (int ks = 0; ks < 2; ++ks) qf[ks] = *(const bf16x8*)(aq + (rowb + t0 + q) * 512 + hq * 64 + ks * 32 + 8 * fq);
        __syncthreads();
        f32x4 sc[9];
#pragma unroll
        for (int jj = 0; jj < 9; ++jj) { const int j = w + jj; f32x4 acc = (f32x4){0.f, 0.f, 0.f, 0.f};
#pragma unroll
            for (int ks = 0; ks < 2; ++ks) { const bf16x8 a = *(const LAS bf16x8*)(lds + L_AK + (16 * j + fr) * 144 + ks * 64 + fq * 16); acc = MFMA16(a, qf[ks], acc); }
            sc[jj] = acc; }
        const float slope = __builtin_amdgcn_exp2f(-(float)(hq + 1)), sink = sinks[hq];
        float mx = sink;
#pragma unroll
        for (int jj = 0; jj < 9; ++jj)
#pragma unroll
            for (int i = 0; i < 4; ++i) { const int key = 16 * (w + jj) + 4 * fq + i, dist = q + 128 - key; const bool valid = dist >= 0 && dist < 128 && (t0 - 128 + key) >= 0;
                const float v = valid ? sc[jj][i] - slope * (float)dist : -INFINITY; sc[jj][i] = v; mx = fmaxf(mx, v); }
        mx = fmaxf(mx, __shfl_xor(mx, 16)); mx = fmaxf(mx, __shfl_xor(mx, 32));
        float l = 0.f;
#pragma unroll
        for (int jj = 0; jj < 9; ++jj)
#pragma unroll
            for (int i = 0; i < 4; ++i) { const float p = fexp(sc[jj][i] - mx); sc[jj][i] = p; l += p; }
        l += __shfl_xor(l, 16); l += __shfl_xor(l, 32);
        l += fexp(sink - mx);
        const float rl = __builtin_amdgcn_rcpf(l);
        bf16x8 pb[5];
#pragma unroll
        for (int J = 0; J < 5; ++J) { u32x4 t; t.x = pk2(sc[2 * J][0], sc[2 * J][1]); t.y = pk2(sc[2 * J][2], sc[2 * J][3]);
            if (2 * J + 1 < 9) { t.z = pk2(sc[(2 * J + 1) % 9][0], sc[(2 * J + 1) % 9][1]); t.w = pk2(sc[(2 * J + 1) % 9][2], sc[(2 * J + 1) % 9][3]); } else { t.z = 0u; t.w = 0u; }
            pb[J] = __builtin_bit_cast(bf16x8, t); }
#pragma unroll
        for (int dt = 0; dt < 4; ++dt) { f32x4 acc = (f32x4){0.f, 0.f, 0.f, 0.f};
#pragma unroll
            for (int J = 0; J < 5; ++J) { const int j0 = w + 2 * J, j1 = (j0 + 1 > 15) ? 15 : j0 + 1;
                const u32x2 lo = *(const LAS u32x2*)(lds + L_AVT + (16 * dt + fr) * 528 + (16 * j0 + 4 * fq) * 2), hi = *(const LAS u32x2*)(lds + L_AVT + (16 * dt + fr) * 528 + (16 * j1 + 4 * fq) * 2);
                u32x4 t; t.x = lo.x; t.y = lo.y; t.z = hi.x; t.w = hi.y;
                acc = MFMA16(__builtin_bit_cast(bf16x8, t), pb[J], acc); }
            u32x2 ov; ov.x = pk2(acc[0] * rl, acc[1] * rl); ov.y = pk2(acc[2] * rl, acc[3] * rl);
            *(u32x2*)(oat + (rowb + t0 + q) * 512 + hq * 64 + 16 * dt + 4 * fq) = ov; }
        __syncthreads();
    }
}

struct Args { const float* in[15]; float* out; unsigned char* ws; int ph_lo, ph_hi; };
constexpr int N_PHASES = 23;
#ifndef ONLY_PHASE
#define ONLY_PHASE -1
#endif
#define PH(kk) ((ONLY_PHASE < 0 || ONLY_PHASE == (kk)) && k == (kk))
__global__ void __launch_bounds__(NWAVES * 64, 2) mega_fwd(Args args) {
    extern __shared__ __attribute__((aligned(16))) unsigned char lds_raw[];
    LAS unsigned char* lds = (LAS unsigned char*)lds_raw;
    const int G = gridDim.x, bx = blockIdx.x;
    unsigned char* ws = args.ws;
    float* xs = args.out;
#pragma nounroll
    for (int ph = args.ph_lo; ph < args.ph_hi; ++ph) {
        const int l = ph / 11, k = ph - 11 * l;
        int tid = threadIdx.x; asm volatile("" : "+v"(tid));
        const int lane = tid & 63, wave = __builtin_amdgcn_readfirstlane(tid >> 6);
        const int gw = bx * NWAVES + wave, ngw = G * NWAVES;
        const float* gains = args.in[1];
        const float* gn = gains + (size_t)(l < 2 ? l : 1) * 6 * DM;
        bf16* HB = (bf16*)(ws + WS_HB); bf16* ACT = (bf16*)(ws + WS_ACT); float* Y = (float*)(ws + WS_Y); float* SS = (float*)(ws + WS_SS); float* Z = (float*)(ws + WS_Z);
        if (PH(0)) {
            if (l < 2) {
                Inputs I; I.x = args.in[0]; I.gains = args.in[1]; I.g1 = args.in[2]; I.u1 = args.in[3]; I.d1 = args.in[4]; I.win = args.in[5]; I.lbraw = args.in[6]; I.hgain = args.in[7]; I.sinks = args.in[8];
                I.wba = args.in[9]; I.wbb = args.in[10]; I.wout = args.in[11]; I.g2 = args.in[12]; I.u2 = args.in[13]; I.d2 = args.in[14];
                convert_layer(I, l, ws, lds, gw, ngw, wave, lane);
            }
            if (l == 0) row_phase(args.in[0], nullptr, nullptr, nullptr, nullptr, 0.f, gn, HB, gw, ngw, lane);
            else row_phase(xs, xs, Y, SS, gains + (size_t)(l - 1) * 6 * DM + 5 * DM, 0.5f, gn, l < 2 ? HB : nullptr, gw, ngw, lane);
            __syncthreads();
        }
        if (PH(1) || PH(9)) { pg8::Gemm g{HB, (const bf16*)(ws + (k == 1 ? WS_WGU1 : WS_WGU2)), NT, 2 * DFF, DM}; pg8::StaticOrder S; S.init(NT, 2 * DFF, G, bx); pg8::EpiGU E{ACT, DFF};
            pg8::gemm_phase<pg8::EpiGU, pg8::StaticOrder, true, true>(lds, g, S, E); }
        if (PH(2) || PH(10)) { pg8::Gemm g{ACT, (const bf16*)(ws + (k == 2 ? WS_WD1 : WS_WD2)), NT, DM, DFF}; pg8::StaticOrder S; S.init(NT, DM, G, bx); pg8::EpiF32SS E{Y, SS};
            pg8::gemm_phase<pg8::EpiF32SS, pg8::StaticOrder, true, true>(lds, g, S, E); }
        if (PH(3)) row_phase(l == 0 ? args.in[0] : xs, xs, Y, SS, gn + 1 * DM, 0.5f, gn + 2 * DM, HB, gw, ngw, lane);
        if (PH(4)) { pg8::Gemm g{HB, (const bf16*)(ws + WS_WIN), NT, DIN, DM}; pg8::StaticOrder S; S.init(NT, DIN, G, bx);
            pg8::EpiProj E{(bf16*)(ws + WS_QS), (bf16*)(ws + WS_KK), (bf16*)(ws + WS_VI), (bf16*)(ws + WS_SG), (bf16*)(ws + WS_AQ), (bf16*)(ws + WS_AK), (bf16*)(ws + WS_AV), (bf16*)(ws + WS_GA), (bf16*)(ws + WS_GB),
                           (float*)(ws + WS_LOGF), args.in[6], l};
            pg8::gemm_phase<pg8::EpiProj, pg8::StaticOrder, true, true>(lds, g, S, E); }
        if (PH(5)) {
#ifndef SKIP_HGRN
            if (bx < 32) hgrn_seq(lds, bx, (const bf16*)(ws + WS_QS), (const float*)(ws + WS_LOGF), (const bf16*)(ws + WS_KK), (const bf16*)(ws + WS_VI), (const bf16*)(ws + WS_SG), args.in[7] + l * 128, (bf16*)(ws + WS_OHG), tid);
#endif
#ifndef SKIP_ATTN
            if (bx >= 32) attn_units(lds, bx - 32, G - 32, (const bf16*)(ws + WS_AQ), (const bf16*)(ws + WS_AK), (const bf16*)(ws + WS_AV), args.in[8] + l * 8, (bf16*)(ws + WS_OAT), tid);
#endif
            __syncthreads();
        }
        if (PH(6)) {
            { pg8::Gemm g{(const bf16*)(ws + WS_OHG), (const bf16*)(ws + WS_WBA), NT, DM, 512}; pg8::StaticOrder S; S.init(NT, DM, G, bx); pg8::EpiMix<0> E{(const bf16*)(ws + WS_GA), (float*)(ws + WS_M1), nullptr};
              pg8::gemm_phase<pg8::EpiMix<0>, pg8::StaticOrder, true, true>(lds, g, S, E); }
            { pg8::Gemm g{(const bf16*)(ws + WS_OAT), (const bf16*)(ws + WS_WBB), NT, DM, 512}; pg8::StaticOrder S; S.init(NT, DM, G, bx); pg8::EpiMix<1> E{(const bf16*)(ws + WS_GB), (float*)(ws + WS_M1), (bf16*)(ws + WS_MIXED)};
              pg8::gemm_phase<pg8::EpiMix<1>, pg8::StaticOrder, true, true>(lds, g, S, E); }
        }
        if (PH(7)) { pg8::Gemm g{(const bf16*)(ws + WS_MIXED), (const bf16*)(ws + WS_WOUT), NT, DM, DM}; pg8::StaticOrder S; S.init(NT, DM, G, bx); pg8::EpiF32SS E{Z, SS};
            pg8::gemm_phase<pg8::EpiF32SS, pg8::StaticOrder, true, true>(lds, g, S, E); }
        if (PH(8)) row_phase(xs, xs, Z, SS, gn + 3 * DM, 1.0f, gn + 4 * DM, HB, gw, ngw, lane);
        if (ph + 1 < args.ph_hi) cg::this_grid().sync();
    }
}
#undef PH

#ifndef MK_ONE_LAUNCH
#define MK_ONE_LAUNCH 1
#endif
extern "C" void kernel_launch(void* const* d_in, const int* in_sizes, int n_in, void* d_out, int out_size, void* d_ws, size_t ws_size, hipStream_t stream) {
    static int grid = 0;
    if (grid == 0) {
        if (n_in != 15 || out_size != NT * DM || ws_size < WS_END) { fprintf(stderr, "kernel_launch: unexpected shapes (n_in %d out %d ws %zu)\n", n_in, out_size, ws_size); grid = -1; return; }
        int dev = 0, cus = 0, per_cu = 0;
        hipGetDevice(&dev); hipDeviceGetAttribute(&cus, hipDeviceAttributeMultiprocessorCount, dev);
        if (hipFuncSetAttribute((const void*)mega_fwd, hipFuncAttributeMaxDynamicSharedMemorySize, LDS_BYTES) != hipSuccess) { fprintf(stderr, "kernel_launch: hipFuncSetAttribute failed\n"); grid = -1; return; }
        if (hipOccupancyMaxActiveBlocksPerMultiprocessor(&per_cu, (const void*)mega_fwd, NWAVES * 64, LDS_BYTES) != hipSuccess || per_cu < 1) { fprintf(stderr, "kernel_launch: occupancy query says %d\n", per_cu); per_cu = 1; }
        (void)hipGetLastError();
        grid = cus;
        fprintf(stderr, "kernel_launch: grid %d (per_cu %d)\n", grid, per_cu);
    }
    if (grid < 0) return;
    Args a{};
    for (int i = 0; i < 15; ++i) a.in[i] = (const float*)d_in[i];
    a.out = (float*)d_out; a.ws = (unsigned char*)d_ws;
#if MK_ONE_LAUNCH
    a.ph_lo = 0; a.ph_hi = N_PHASES;
    void* kargs[] = {&a};
    hipError_t e = hipLaunchCooperativeKernel((const void*)mega_fwd, dim3(grid), dim3(NWAVES * 64), kargs, LDS_BYTES, stream);
    if (e != hipSuccess) fprintf(stderr, "cooperative launch failed: %s (grid %d)\n", hipGetErrorString(e), grid);
#else
    for (int p = 0; p < N_PHASES; ++p) { a.ph_lo = p; a.ph_hi = p + 1; hipLaunchKernelGGL(mega_fwd, dim3(grid), dim3(NWAVES * 64), LDS_BYTES, stream, a); }
#endif
}
```

```cpp
#include <hip/hip_runtime.h>
#include <hip/hip_cooperative_groups.h>
#include <cstdio>
#include <cstdint>
namespace cg = cooperative_groups;
namespace pg8 {
#define PG8_LAS __attribute__((address_space(3)))
typedef unsigned short bf16_t;
typedef short bf16x8 __attribute__((ext_vector_type(8)));
typedef float f32x4 __attribute__((ext_vector_type(4)));
typedef unsigned u32x4 __attribute__((ext_vector_type(4)));
constexpr int BM = 256, BK = 64, HALF = 128, HTB = HALF * BK * 2  , STAGE_BYTES = 8 * HTB, NXCD = 8, WGM = 8;

__host__ __device__ __forceinline__ int lds_byte(int r, int c) { const int st = (r >> 4) * 2 + (c >> 5), rr = r & 15, cc = c & 31, ob = rr * 64 + cc * 2; return st * 1024 + (ob ^ (((ob >> 9) & 1) << 5)); }
__host__ __device__ __forceinline__ void stage_rc(int b, int& R, int& C) { const int st = b / 1024, sb = b % 1024, swz = sb ^ (((sb >> 9) & 1) << 5); R = (st >> 1) * 16 + swz / 64; C = (st & 1) * 32 + (swz % 64) / 2; }
__host__ __device__ __forceinline__ int perm32(int rho) { const int n = rho >> 4, i = rho & 15; return 8 * (i >> 2) + 4 * n + (i & 3); }

struct Unit { int pm, pn; };
struct Gemm { const bf16_t* A; const bf16_t* Bt; int M, N, K; };

struct StaticOrder {
    int nM, nN, nwg, G, c;
    __host__ __device__ void init(int M, int N, int G_, int c_) { nM = M / BM; nN = N / BM; nwg = nM * nN; G = G_; c = c_; }
    __host__ __device__ bool next(int i, Unit& u) const {
        const long L = (long)i * G + c; if (L >= nwg) return false;
        int wgid = (int)L; { const int q = nwg / NXCD, r = nwg % NXCD, xcd = wgid % NXCD, off = wgid / NXCD; wgid = (xcd < r ? xcd * (q + 1) : r * (q + 1) + (xcd - r) * q) + off; }
        const int nig = WGM * nN, gid = wgid / nig, fm = gid * WGM, gsz = (nM - fm) < WGM ? (nM - fm) : WGM;
        u.pm = fm + ((wgid % nig) % gsz); u.pn = (wgid % nig) / gsz; return true;
    }
    __device__ __forceinline__ void a_ready(const Unit&) const {}
    __device__ __forceinline__ void done(const Unit&) const {}
};

__device__ __forceinline__ unsigned cvt_pk_bf16(float lo, float hi) { unsigned r; asm volatile("v_cvt_pk_bf16_f32 %0, %1, %2" : "=v"(r) : "v"(lo), "v"(hi)); return r; }
typedef float f32x2 __attribute__((ext_vector_type(2)));
typedef unsigned u32x2 __attribute__((ext_vector_type(2)));
__device__ __forceinline__ float fexp(float x) { return __builtin_amdgcn_exp2f(x * 1.4426950408889634f); }
__device__ __forceinline__ float fsigmoid(float x) { return __builtin_amdgcn_rcpf(1.0f + fexp(-x)); }
__device__ __forceinline__ float fsilu(float x) { return x * fsigmoid(x); }
__device__ __forceinline__ float bflo(unsigned u) { return __uint_as_float(u << 16); }
__device__ __forceinline__ float bfhi(unsigned u) { return __uint_as_float(u & 0xffff0000u); }
__device__ __forceinline__ u32x4 pack8(const f32x4& a, const f32x4& b) { u32x4 w; w.x = cvt_pk_bf16(a[0], a[1]); w.y = cvt_pk_bf16(a[2], a[3]); w.z = cvt_pk_bf16(b[0], b[1]); w.w = cvt_pk_bf16(b[2], b[3]); return w; }

struct EpiGU {
    static constexpr bool PERM = true, AFTER_DRAIN = false;
    bf16_t* O; int ldo;
    __device__ __forceinline__ void operator()(const f32x4 (&acc)[2][2][4][2], const Unit& u, int wr, int wc, int fr, int fq) const {
        const int row0 = u.pm * BM + wr * 64 + fr, col = u.pn * 128 + wc * 32 + 8 * fq;
#pragma unroll
        for (int ai = 0; ai < 2; ++ai)
#pragma unroll
            for (int m = 0; m < 4; ++m) {
                f32x4 a0, a1;
#pragma unroll
                for (int i = 0; i < 4; ++i) { a0[i] = fsilu(acc[ai][0][m][0][i]) * acc[ai][1][m][0][i]; a1[i] = fsilu(acc[ai][0][m][1][i]) * acc[ai][1][m][1][i]; }
                *(u32x4*)(O + (size_t)(row0 + ai * HALF + m * 16) * ldo + col) = pack8(a0, a1);
            }
    }
};
struct EpiF32SS {
    static constexpr bool PERM = true, AFTER_DRAIN = false;
    float* Y; float* SS;
    __device__ __forceinline__ void operator()(const f32x4 (&acc)[2][2][4][2], const Unit& u, int wr, int wc, int fr, int fq) const {
        const int row0 = u.pm * BM + wr * 64 + fr, col = u.pn * BM + wc * 32 + 8 * fq;
#pragma unroll
        for (int ai = 0; ai < 2; ++ai)
#pragma unroll
            for (int m = 0; m < 4; ++m) {
                const int row = row0 + ai * HALF + m * 16; float s = 0.f;
#pragma unroll
                for (int bj = 0; bj < 2; ++bj) { const f32x4 v0 = acc[ai][bj][m][0], v1 = acc[ai][bj][m][1]; float* p = Y + (size_t)row * 1024 + col + bj * HALF;
                    *(f32x4*)p = v0; *(f32x4*)(p + 4) = v1;
                    s += (v0[0] * v0[0] + v0[1] * v0[1]) + (v0[2] * v0[2] + v0[3] * v0[3]) + (v1[0] * v1[0] + v1[1] * v1[1]) + (v1[2] * v1[2] + v1[3] * v1[3]); }
                s += __shfl_xor(s, 16); s += __shfl_xor(s, 32);
                if (fq == 0) SS[(size_t)row * 16 + u.pn * 4 + wc] = s;
            }
    }
};
struct EpiProj {
    static constexpr bool PERM = true, AFTER_DRAIN = false;
    bf16_t *qs, *kk, *vi, *sg, *aq, *ak, *av, *ga, *gb; float* logf; const float* lbraw; int layer;
#define PROJ_LOOP(...) _Pragma("unroll") for (int ai = 0; ai < 2; ++ai) _Pragma("unroll") for (int m = 0; m < 4; ++m) { const size_t row = (size_t)(row0 + ai * HALF + m * 16); \
        _Pragma("unroll") for (int bj = 0; bj < 2; ++bj) { f32x4 v0 = acc[ai][bj][m][0], v1 = acc[ai][bj][m][1]; const int c0 = cb + bj * HALF; __VA_ARGS__ } asm volatile("" ::: "memory"); }
    __device__ __forceinline__ void operator()(const f32x4 (&acc)[2][2][4][2], const Unit& u, int wr, int wc, int fr, int fq) const {
        const int row0 = u.pm * BM + wr * 64 + fr, pn = u.pn, cb = (pn & 1) * BM + wc * 32 + 8 * fq;
        if (pn < 2) {
            PROJ_LOOP({ _Pragma("unroll") for (int i = 0; i < 4; ++i) { v0[i] = fsilu(v0[i]); v1[i] = fsilu(v1[i]); } *(u32x4*)(qs + row * 512 + c0) = pack8(v0, v1); })
        } else if (pn < 4) {
            float lb[2][8];
#pragma unroll
            for (int bj = 0; bj < 2; ++bj)
#pragma unroll
                for (int i = 0; i < 8; ++i) { lb[bj][i] = 0.f; if (layer == 1) { const float b0 = lbraw[cb + bj * HALF + i], b1 = lbraw[512 + cb + bj * HALF + i]; lb[bj][i] = __builtin_amdgcn_rcpf(1.0f + fexp(b0 - b1)); } }
            PROJ_LOOP({ f32x4 l0, l1, k0, k1;
                _Pragma("unroll") for (int i = 0; i < 4; ++i) { const float a0 = lb[bj][i], a1 = lb[bj][4 + i];
                    const float f0 = a0 + (1.f - a0) * fsigmoid(v0[i]), f1 = a1 + (1.f - a1) * fsigmoid(v1[i]);
                    l0[i] = __logf(f0); l1[i] = __logf(f1); k0[i] = (1.f - a0) * fsigmoid(-v0[i]); k1[i] = (1.f - a1) * fsigmoid(-v1[i]); }
                float* lp = logf + row * 512 + c0; *(f32x4*)lp = l0; *(f32x4*)(lp + 4) = l1; *(u32x4*)(kk + row * 512 + c0) = pack8(k0, k1); })
        } else if (pn < 6) {
            PROJ_LOOP({ *(u32x4*)(vi + row * 512 + c0) = pack8(v0, v1); })
        } else if (pn < 8) {
            PROJ_LOOP({ _Pragma("unroll") for (int i = 0; i < 4; ++i) { v0[i] = fsilu(v0[i]); v1[i] = fsilu(v1[i]); } *(u32x4*)(sg + row * 512 + c0) = pack8(v0, v1); })
        } else if (pn < 10) {
            PROJ_LOOP({ v0 = v0 * 0.125f; v1 = v1 * 0.125f; *(u32x4*)(aq + row * 512 + c0) = pack8(v0, v1); })
        } else if (pn == 10) {
            PROJ_LOOP({ bf16_t* dst = bj == 0 ? ak : av; *(u32x4*)(dst + row * 128 + (c0 & 127)) = pack8(v0, v1); })
        } else {
            bf16_t* gdst = pn < 15 ? ga + (pn - 11) * BM : gb + (pn - 15) * BM; const int cg2 = wc * 32 + 8 * fq;
            PROJ_LOOP({ _Pragma("unroll") for (int i = 0; i < 4; ++i) { v0[i] = fsigmoid(v0[i]); v1[i] = fsigmoid(v1[i]); } (void)c0; *(u32x4*)(gdst + row * 1024 + cg2 + bj * HALF) = pack8(v0, v1); })
        }
    }
#undef PROJ_LOOP
};
template <int SECOND> struct EpiMix {
    static constexpr bool PERM = true, AFTER_DRAIN = false;
    const bf16_t* gate; float* m1; bf16_t* mixed;
    __device__ __forceinline__ void operator()(const f32x4 (&acc)[2][2][4][2], const Unit& u, int wr, int wc, int fr, int fq) const {
        const int row0 = u.pm * BM + wr * 64 + fr, col = u.pn * BM + wc * 32 + 8 * fq;
#pragma unroll
        for (int ai = 0; ai < 2; ++ai)
#pragma unroll
            for (int m = 0; m < 4; ++m)
#pragma unroll
                for (int bj = 0; bj < 2; ++bj) {
                    const size_t off = (size_t)(row0 + ai * HALF + m * 16) * 1024 + col + bj * HALF;
                    const u32x4 g = *(const u32x4*)(gate + off);
                    f32x4 v0 = acc[ai][bj][m][0], v1 = acc[ai][bj][m][1];
                    v0[0] *= bflo(g.x); v0[1] *= bfhi(g.x); v0[2] *= bflo(g.y); v0[3] *= bfhi(g.y);
                    v1[0] *= bflo(g.z); v1[1] *= bfhi(g.z); v1[2] *= bflo(g.w); v1[3] *= bfhi(g.w);
                    if (SECOND == 0) { *(f32x4*)(m1 + off) = v0; *(f32x4*)(m1 + off + 4) = v1; }
                    else { v0 = v0 + *(const f32x4*)(m1 + off); v1 = v1 + *(const f32x4*)(m1 + off + 4); *(u32x4*)(mixed + off) = pack8(v0, v1); }
                    asm volatile("" ::: "memory");
                }
    }
};
template <class Epi, class Sched, bool ALIGN_EPI = false, bool SP2 = false>
__device__ __forceinline__ void gemm_phase(PG8_LAS unsigned char* lds, const Gemm g, const Sched& S, const Epi& E) {
    int tid_ = threadIdx.x; asm volatile("" : "+v"(tid_)); const int tid = tid_, wid = __builtin_amdgcn_readfirstlane(tid >> 6), lane = tid & 63, wr = wid >> 2, wc = wid & 3, fr = lane & 15, fq = lane >> 4;
    const int K = g.K, nt = K / BK;
    unsigned voffA[2], voffB[2];
#pragma unroll
    for (int i = 0; i < 2; ++i) { int R, C; stage_rc(tid * 16 + i * 8192, R, C); const int Rb = Epi::PERM ? ((R & ~31) + perm32(R & 31)) : R;
        voffA[i] = (unsigned)(R * K + C) * 2u; voffB[i] = (unsigned)(Rb * K + C) * 2u; }
    const size_t kstep = (size_t)(BK * 2);
    const size_t hstep = (size_t)HALF * K * 2;
    const size_t tstep = 2 * hstep;
    const unsigned ldsw = (unsigned)wid * 1024u;
    const int aoff = lds_byte(wr * 64 + fr, fq * 8), boff = lds_byte(wc * 32 + fr, fq * 8);
#define PG8_SA(b, h) (((b) * 2 + (h)) * HTB)
#define PG8_SB(b, h) ((4 + (b) * 2 + (h)) * HTB)
#define PG8_STAGE(bufoff, gbase, voff) do { _Pragma("unroll") for (int _i = 0; _i < 2; ++_i) \
        __builtin_amdgcn_global_load_lds((const unsigned*)((const char*)(gbase) + (voff)[_i]), (PG8_LAS unsigned*)(lds + (bufoff) + ldsw + _i * 8192), 16, 0, 0); } while (0)
#define PG8_LDA(dst, b, h) do { _Pragma("unroll") for (int m = 0; m < 4; ++m) _Pragma("unroll") for (int k = 0; k < 2; ++k) dst[m][k] = *(const PG8_LAS bf16x8*)(lds + PG8_SA(b, h) + aoff + m * 2048 + k * 1024); } while (0)
#define PG8_LDB(dst, b, h) do { _Pragma("unroll") for (int n = 0; n < 2; ++n) _Pragma("unroll") for (int k = 0; k < 2; ++k) dst[n][k] = *(const PG8_LAS bf16x8*)(lds + PG8_SB(b, h) + boff + n * 2048 + k * 1024); } while (0)
#define PG8_MMA(ai, bj, At, Bt) do { __builtin_amdgcn_s_setprio(1); _Pragma("unroll") for (int m = 0; m < 4; ++m) _Pragma("unroll") for (int n = 0; n < 2; ++n) _Pragma("unroll") for (int k = 0; k < 2; ++k) \
        acc[ai][bj][m][n] = __builtin_amdgcn_mfma_f32_16x16x32_bf16(Bt[n][k], At[m][k], acc[ai][bj][m][n], 0, 0, 0); __builtin_amdgcn_s_setprio(0); } while (0)
#define PG8_WAIT_V(n) asm volatile("s_waitcnt vmcnt(" #n ")" ::: "memory")
#define PG8_WAIT_L(n) asm volatile("s_waitcnt lgkmcnt(" #n ")" ::: "memory")
#define PG8_BAR __builtin_amdgcn_s_barrier()
#define PG8_SCHED __builtin_amdgcn_sched_barrier(0)
    Unit cur, nxt; int ui = 0;
    if (!S.next(0, cur)) return;
    f32x4 acc[2][2][4][2];
#pragma unroll
    for (int a = 0; a < 2; ++a)
#pragma unroll
        for (int b = 0; b < 2; ++b)
#pragma unroll
            for (int m = 0; m < 4; ++m)
#pragma unroll
                for (int n = 0; n < 2; ++n) acc[a][b][m][n] = (f32x4){0.f, 0.f, 0.f, 0.f};
    bf16x8 At[4][2], B0[2][2], B1[2][2];
    const char* cA = (const char*)g.A + (size_t)cur.pm * tstep; const char* cB = (const char*)g.Bt + (size_t)cur.pn * tstep;
    S.a_ready(cur);
    if constexpr (SP2) {
        PG8_STAGE(PG8_SB(0, 0), cB, voffB); PG8_STAGE(PG8_SB(0, 1), cB + hstep, voffB); PG8_STAGE(PG8_SA(0, 0), cA, voffA); PG8_STAGE(PG8_SA(0, 1), cA + hstep, voffA);
        if (wr == 1) PG8_BAR;
        PG8_WAIT_V(2); PG8_BAR;
        PG8_STAGE(PG8_SB(1, 0), cB + kstep, voffB); PG8_STAGE(PG8_SA(1, 0), cA + kstep, voffA); PG8_STAGE(PG8_SB(1, 1), cB + hstep + kstep, voffB);
        PG8_WAIT_V(6); PG8_BAR;
    } else {
        PG8_STAGE(PG8_SB(0, 0), cB, voffB); PG8_STAGE(PG8_SA(0, 0), cA, voffA); PG8_STAGE(PG8_SB(0, 1), cB + hstep, voffB); PG8_STAGE(PG8_SA(0, 1), cA + hstep, voffA);
        if (wr == 1) PG8_BAR;
        PG8_WAIT_V(4); PG8_BAR;
        PG8_STAGE(PG8_SB(1, 0), cB + kstep, voffB); PG8_STAGE(PG8_SA(1, 0), cA + kstep, voffA); PG8_STAGE(PG8_SB(1, 1), cB + hstep + kstep, voffB);
        PG8_WAIT_V(6); PG8_BAR;
    }
    for (;;) {
        const bool has_next = S.next(ui + 1, nxt);
        const char* nA = has_next ? (const char*)g.A + (size_t)nxt.pm * tstep : cA; const char* nB = has_next ? (const char*)g.Bt + (size_t)nxt.pn * tstep : cB;
        for (int t = 0; t < nt; t += 2) {
            const bool last = (t == nt - 2);
            const char* a1 = cA + (size_t)(t + 1) * kstep;
            const char* a2 = last ? nA : cA + (size_t)(t + 2) * kstep; const char* b2 = last ? nB : cB + (size_t)(t + 2) * kstep;
            const char* a3 = a2 + kstep; const char* b3 = b2 + kstep;
            if (last && has_next) S.a_ready(nxt);
            if constexpr (SP2) {
            PG8_LDB(B0, 0, 0); PG8_LDB(B1, 0, 1); PG8_SCHED; PG8_LDA(At, 0, 0); PG8_STAGE(PG8_SA(1, 1), a1 + hstep, voffA);
            PG8_WAIT_V(8); PG8_WAIT_L(0); PG8_BAR; PG8_MMA(0, 0, At, B0); PG8_MMA(0, 1, At, B1); PG8_BAR; PG8_SCHED;
            PG8_LDA(At, 0, 1); PG8_STAGE(PG8_SB(0, 0), b2, voffB); PG8_STAGE(PG8_SB(0, 1), b2 + hstep, voffB); PG8_STAGE(PG8_SA(0, 0), a2, voffA);
            PG8_WAIT_V(8); PG8_WAIT_L(0); PG8_BAR; PG8_MMA(1, 0, At, B0); PG8_MMA(1, 1, At, B1); PG8_BAR; PG8_SCHED;
            PG8_LDB(B0, 1, 0); PG8_LDB(B1, 1, 1); PG8_SCHED; PG8_LDA(At, 1, 0); PG8_STAGE(PG8_SA(0, 1), a2 + hstep, voffA);
            PG8_WAIT_V(8); PG8_WAIT_L(0); PG8_BAR; PG8_MMA(0, 0, At, B0); PG8_MMA(0, 1, At, B1); PG8_BAR; PG8_SCHED;
            PG8_LDA(At, 1, 1); PG8_STAGE(PG8_SB(1, 0), b3, voffB); PG8_STAGE(PG8_SB(1, 1), b3 + hstep, voffB); PG8_STAGE(PG8_SA(1, 0), a3, voffA);
            PG8_WAIT_V(8); PG8_WAIT_L(0); PG8_BAR; PG8_MMA(1, 0, At, B0); PG8_MMA(1, 1, At, B1); PG8_BAR; PG8_SCHED;
            } else {
            PG8_LDB(B0, 0, 0); PG8_SCHED; PG8_LDA(At, 0, 0); PG8_STAGE(PG8_SA(1, 1), a1 + hstep, voffA);
            PG8_WAIT_L(8); PG8_BAR; PG8_WAIT_L(0); PG8_MMA(0, 0, At, B0); PG8_BAR; PG8_SCHED;
            PG8_LDB(B1, 0, 1); PG8_STAGE(PG8_SB(0, 0), b2, voffB);
            PG8_BAR; PG8_WAIT_L(0); PG8_MMA(0, 1, At, B1); PG8_BAR;
            PG8_LDA(At, 0, 1); PG8_STAGE(PG8_SA(0, 0), a2, voffA);
            PG8_BAR; PG8_WAIT_L(0); PG8_MMA(1, 0, At, B0); PG8_BAR; PG8_SCHED;
            PG8_STAGE(PG8_SB(0, 1), b2 + hstep, voffB);
            PG8_WAIT_V(6); PG8_BAR; PG8_MMA(1, 1, At, B1); PG8_BAR;
            PG8_LDB(B0, 1, 0); PG8_SCHED; PG8_LDA(At, 1, 0); PG8_STAGE(PG8_SA(0, 1), a2 + hstep, voffA);
            PG8_WAIT_L(8); PG8_BAR; PG8_WAIT_L(0); PG8_MMA(0, 0, At, B0); PG8_BAR; PG8_SCHED;
            PG8_LDB(B1, 1, 1); PG8_STAGE(PG8_SB(1, 0), b3, voffB);
            PG8_BAR; PG8_WAIT_L(0); PG8_MMA(0, 1, At, B1); PG8_BAR;
            PG8_LDA(At, 1, 1); PG8_STAGE(PG8_SA(1, 0), a3, voffA);
            PG8_BAR; PG8_WAIT_L(0); PG8_MMA(1, 0, At, B0); PG8_BAR; PG8_SCHED;
            PG8_STAGE(PG8_SB(1, 1), b3 + hstep, voffB);
            PG8_WAIT_V(6); PG8_BAR; PG8_MMA(1, 1, At, B1); PG8_BAR;
            }
        }
        if constexpr (ALIGN_EPI) { if (wr == 0) PG8_BAR; }
        if constexpr (!Epi::AFTER_DRAIN) { E(acc, cur, wr, wc, fr, fq); S.done(cur); }
        if (!has_next) break;
#pragma unroll
        for (int a = 0; a < 2; ++a)
#pragma unroll
            for (int b = 0; b < 2; ++b)
#pragma unroll
                for (int m = 0; m < 4; ++m)
#pragma unroll
                    for (int n = 0; n < 2; ++n) acc[a][b][m][n] = (f32x4){0.f, 0.f, 0.f, 0.f};
        cur = nxt; cA = nA; cB = nB; ++ui;
        if constexpr (ALIGN_EPI) { if (wr == 1) PG8_BAR; }
    }
    PG8_WAIT_V(0);
    if constexpr (!ALIGN_EPI) { if (wr == 0) PG8_BAR; }
    PG8_BAR;
    if constexpr (Epi::AFTER_DRAIN) { E.fused(acc, cur, wr, wc, fr, fq, lds, wid, lane); S.done(cur); }
#undef PG8_SA
#undef PG8_SB
#undef PG8_STAGE
#undef PG8_LDA
#undef PG8_LDB
#undef PG8_MMA
#undef PG8_WAIT_V
#undef PG8_WAIT_L
#undef PG8_BAR
#undef PG8_SCHED
}
}
#define LAS __attribute__((address_space(3)))
typedef unsigned short bf16;
typedef float f32x4 __attribute__((ext_vector_type(4)));
typedef short bf16x8 __attribute__((ext_vector_type(8)));
typedef unsigned u32x4 __attribute__((ext_vector_type(4)));
typedef unsigned u32x2 __attribute__((ext_vector_type(2)));
constexpr int NT = 16384, DM = 1024, DFF = 2816, DIN = 4864, SEQ = 2048, NWAVES = 8;
constexpr float EPS = 1e-6f;
constexpr size_t HM = 512u * 1024u;
constexpr size_t WS_SS = 2 * HM;
constexpr size_t WS_WIN = 4 * HM, WS_WBA = 23 * HM, WS_WBB = 25 * HM, WS_WOUT = 27 * HM, WS_WGU2 = 31 * HM, WS_WD2 = 53 * HM;
constexpr size_t WS_WGU1 = 64 * HM, WS_WD1 = 86 * HM;
constexpr size_t WS_KK = 64 * HM;
constexpr size_t WS_HB = 98 * HM;
constexpr size_t WS_OHG = 98 * HM, WS_OAT = 130 * HM;
constexpr size_t WS_ACT = 162 * HM;
constexpr size_t WS_Y = 338 * HM;
constexpr size_t WS_QS = 162 * HM, WS_VI = 194 * HM, WS_SG = 226 * HM, WS_AQ = 258 * HM, WS_AK = 290 * HM, WS_AV = 298 * HM, WS_LOGF = 306 * HM, WS_GA = 370 * HM, WS_GB = 434 * HM;
constexpr size_t WS_M1 = 162 * HM, WS_Z = 162 * HM, WS_MIXED = 306 * HM, WS_END = 512 * HM;
static_assert(WS_GB + 64 * HM <= WS_END && WS_Y + 128 * HM <= WS_END && WS_WD1 + 11 * HM <= WS_HB && WS_WD2 + 11 * HM <= WS_WGU1, "ws map");
constexpr int RING_BYTES = 131072, LDS_BYTES = 147456;

__device__ __forceinline__ unsigned f2bf(float f) { unsigned u = __builtin_bit_cast(unsigned, f); return (u + 0x7fffu + ((u >> 16) & 1u)) >> 16; }
__device__ __forceinline__ unsigned pk2(float lo, float hi) { return pg8::cvt_pk_bf16(lo, hi); }
__device__ __forceinline__ float bflo(unsigned u) { return __uint_as_float(u << 16); }
__device__ __forceinline__ float bfhi(unsigned u) { return __uint_as_float(u & 0xffff0000u); }
__device__ __forceinline__ float fexp(float x) { return __builtin_amdgcn_exp2f(x * 1.4426950408889634f); }
__device__ __forceinline__ float wave_sum(float v) {
#pragma unroll
    for (int o = 1; o < 64; o <<= 1) v += __shfl_xor(v, o);
    return v;
}
#define MFMA16(a, b, c) __builtin_amdgcn_mfma_f32_16x16x32_bf16((a), (b), (c), 0, 0, 0)

__device__ __forceinline__ void transpose_item(const float* W, int K, int N, bf16* WT, int gu, LAS float* scr, int item, int lane) {
    const int nblk = N / 32, kb = item / nblk, nb = item % nblk, k0 = 64 * kb, n0 = 32 * nb;
    const int r0 = gu ? (256 * (n0 >> 7) + (n0 & 127) + 128 * (gu - 1)) : n0;
#pragma unroll 8
    for (int i = 0; i < 32; ++i) { const int kk = 2 * i + (lane >> 5); scr[kk * 33 + (lane & 31)] = W[(size_t)(k0 + kk) * N + n0 + (lane & 31)]; }
    asm volatile("s_waitcnt lgkmcnt(0)" ::: "memory");
    const int c = lane & 7;
#pragma unroll
    for (int j = 0; j < 4; ++j) { const int n = (lane >> 3) + 8 * j; const LAS float* s = scr + (8 * c) * 33 + n;
        u32x4 o; o.x = pk2(s[0 * 33], s[1 * 33]); o.y = pk2(s[2 * 33], s[3 * 33]); o.z = pk2(s[4 * 33], s[5 * 33]); o.w = pk2(s[6 * 33], s[7 * 33]);
        *(u32x4*)(WT + (size_t)(r0 + n) * K + k0 + 8 * c) = o; }
    asm volatile("s_waitcnt lgkmcnt(0)" ::: "memory");
}
struct Inputs { const float *x, *gains, *g1, *u1, *d1, *win, *lbraw, *hgain, *sinks, *wba, *wbb, *wout, *g2, *u2, *d2; };
__device__ __forceinline__ void convert_layer(const Inputs& I, int l, unsigned char* ws, LAS unsigned char* lds, int gw, int ngw, int wave, int lane) {
    LAS float* scr = (LAS float*)(lds + wave * 16384);
    constexpr int I_G = 16 * 88, I_D = 44 * 32, I_IN = 16 * 152, I_B = 8 * 32, I_O = 16 * 32;
    constexpr int NITEMS = 6 * I_G + I_IN + 2 * I_B + I_O;
    const size_t oF = (size_t)l * DM * DFF, oIn = (size_t)l * DM * DIN, oB = (size_t)l * 512 * DM, oO = (size_t)l * DM * DM;
    for (int it = gw; it < NITEMS; it += ngw) {
        int r = it;
        if (r < I_G) { transpose_item(I.g1 + oF, DM, DFF, (bf16*)(ws + WS_WGU1), 1, scr, r, lane); continue; } r -= I_G;
        if (r < I_G) { transpose_item(I.u1 + oF, DM, DFF, (bf16*)(ws + WS_WGU1), 2, scr, r, lane); continue; } r -= I_G;
        if (r < I_D) { transpose_item(I.d1 + oF, DFF, DM, (bf16*)(ws + WS_WD1), 0, scr, r, lane); continue; } r -= I_D;
        if (r < I_IN) { transpose_item(I.win + oIn, DM, DIN, (bf16*)(ws + WS_WIN), 0, scr, r, lane); continue; } r -= I_IN;
        if (r < I_B) { transpose_item(I.wba + oB, 512, DM, (bf16*)(ws + WS_WBA), 0, scr, r, lane); continue; } r -= I_B;
        if (r < I_B) { transpose_item(I.wbb + oB, 512, DM, (bf16*)(ws + WS_WBB), 0, scr, r, lane); continue; } r -= I_B;
        if (r < I_O) { transpose_item(I.wout + oO, DM, DM, (bf16*)(ws + WS_WOUT), 0, scr, r, lane); continue; } r -= I_O;
        if (r < I_G) { transpose_item(I.g2 + oF, DM, DFF, (bf16*)(ws + WS_WGU2), 1, scr, r, lane); continue; } r -= I_G;
        if (r < I_G) { transpose_item(I.u2 + oF, DM, DFF, (bf16*)(ws + WS_WGU2), 2, scr, r, lane); continue; } r -= I_G;
        transpose_item(I.d2 + oF, DFF, DM, (bf16*)(ws + WS_WD2), 0, scr, r, lane);
    }
}
__device__ __forceinline__ void row_phase(const float* xsrc, float* xdst, const float* y, const float* ss, const float* gpost, float coef, const float* gpre, bf16* hb, int gw, int ngw, int lane) {
    for (int m = gw; m < NT; m += ngw) {
        const f32x4* xr = (const f32x4*)(xsrc + (size_t)m * DM) + lane;
        f32x4 v[4];
#pragma unroll
        for (int j = 0; j < 4; ++j) v[j] = xr[64 * j];
        if (y) {
            float s = ss[(size_t)m * 16 + (lane & 15)];
            s += __shfl_xor(s, 1); s += __shfl_xor(s, 2); s += __shfl_xor(s, 4); s += __shfl_xor(s, 8);
            const float r = coef * __builtin_amdgcn_rsqf(s * (1.f / DM) + EPS);
            const f32x4* yr = (const f32x4*)(y + (size_t)m * DM) + lane; const f32x4* gp = (const f32x4*)gpost + lane;
#pragma unroll
            for (int j = 0; j < 4; ++j) v[j] = v[j] + yr[64 * j] * gp[64 * j] * r;
        }
        if (xdst) { f32x4* xo = (f32x4*)(xdst + (size_t)m * DM) + lane;
#pragma unroll
            for (int j = 0; j < 4; ++j) xo[64 * j] = v[j]; }
        if (hb) {
            float s2 = 0.f;
#pragma unroll
            for (int j = 0; j < 4; ++j) s2 += (v[j].x * v[j].x + v[j].y * v[j].y) + (v[j].z * v[j].z + v[j].w * v[j].w);
            const float r2 = __builtin_amdgcn_rsqf(wave_sum(s2) * (1.f / DM) + EPS);
            const f32x4* gq = (const f32x4*)gpre + lane; u32x2* o8 = (u32x2*)(hb + (size_t)m * DM) + lane;
#pragma unroll
            for (int j = 0; j < 4; ++j) { const f32x4 g = gq[64 * j]; u32x2 o; o.x = pk2(v[j].x * r2 * g.x, v[j].y * r2 * g.y); o.y = pk2(v[j].z * r2 * g.z, v[j].w * r2 * g.w); o8[64 * j] = o; }
        }
    }
}

__device__ __forceinline__ void hgrn_seq(LAS unsigned char* lds, int bh, const bf16* qs, const float* logf, const bf16* kk, const bf16* vi, const bf16* sg, const float* hgain, bf16* ohg, int tid) {
    const int lane = tid & 63, w = __builtin_amdgcn_readfirstlane(tid >> 6), fr = lane & 15, fq = lane >> 4;
    const int b = bh >> 2, h = bh & 3;
    constexpr int L_Q = 0, L_K = 17408, L_KT = 34816, L_VT = 53248, L_ST = 71680, L_P = 106496, L_WT = 115712, L_VEC = 119808, L_SSX = 121344;
    static_assert(L_SSX + 512 <= RING_BYTES, "hgrn lds");
    const int cgp = tid & 15, rg = tid >> 4;
    f32x4 S[8];
#pragma unroll
    for (int j = 0; j < 8; ++j) S[j] = (f32x4){0.f, 0.f, 0.f, 0.f};
    const size_t rowb = (size_t)b * SEQ; const int colg = h * 128 + 8 * cgp;
    f32x4 lf[2][2]; u32x4 qv[2], kv[2], vv[2];
#define HG_LOAD(c) do { _Pragma("unroll") for (int rr = 0; rr < 2; ++rr) { const size_t off = (rowb + 64 * (c) + 2 * rg + rr) * 512 + colg; \
        lf[rr][0] = *(const f32x4*)(logf + off); lf[rr][1] = *(const f32x4*)(logf + off + 4); qv[rr] = *(const u32x4*)(qs + off); kv[rr] = *(const u32x4*)(kk + off); vv[rr] = *(const u32x4*)(vi + off); } } while (0)
    HG_LOAD(0);
#pragma nounroll
    for (int c = 0; c < 32; ++c) {
        float G0[8], G1[8], pin[8];
#pragma unroll
        for (int j = 0; j < 8; ++j) { G0[j] = lf[0][j >> 2][j & 3]; G1[j] = G0[j] + lf[1][j >> 2][j & 3];
            float x = G1[j]; float y = __shfl_up(x, 16); if (lane >= 16) x += y; y = __shfl_up(x, 32); if (lane >= 32) x += y;
            pin[j] = x - G1[j];
            if (lane >= 48) *(LAS float*)(lds + L_WT + (w * 128 + 8 * cgp + j) * 4) = x; }
        float qf[2][8], kf[2][8]; unsigned vb[2][4];
#pragma unroll
        for (int rr = 0; rr < 2; ++rr) {
            qf[rr][0] = bflo(qv[rr].x); qf[rr][1] = bfhi(qv[rr].x); qf[rr][2] = bflo(qv[rr].y); qf[rr][3] = bfhi(qv[rr].y); qf[rr][4] = bflo(qv[rr].z); qf[rr][5] = bfhi(qv[rr].z); qf[rr][6] = bflo(qv[rr].w); qf[rr][7] = bfhi(qv[rr].w);
            kf[rr][0] = bflo(kv[rr].x); kf[rr][1] = bfhi(kv[rr].x); kf[rr][2] = bflo(kv[rr].y); kf[rr][3] = bfhi(kv[rr].y); kf[rr][4] = bflo(kv[rr].z); kf[rr][5] = bfhi(kv[rr].z); kf[rr][6] = bflo(kv[rr].w); kf[rr][7] = bfhi(kv[rr].w);
            vb[rr][0] = vv[rr].x; vb[rr][1] = vv[rr].y; vb[rr][2] = vv[rr].z; vb[rr][3] = vv[rr].w;
        }
        __syncthreads();
        float pre[8], gref[8], glast[8];
#pragma unroll
        for (int j = 0; j < 8; ++j) { pre[j] = 0.f; gref[j] = 0.f; glast[j] = 0.f; }
#pragma unroll
        for (int w2 = 0; w2 < 8; ++w2) { const f32x4 a = *(const LAS f32x4*)(lds + L_WT + (w2 * 128 + 8 * cgp) * 4), bq = *(const LAS f32x4*)(lds + L_WT + (w2 * 128 + 8 * cgp + 4) * 4);
#pragma unroll
            for (int j = 0; j < 8; ++j) { const float t = j < 4 ? a[j & 3] : bq[j & 3]; if (w2 < w) pre[j] += t; if (w2 < 4) gref[j] += t; glast[j] += t; } }
        {
            float qt[2][8], kt[2][8];
#pragma unroll
            for (int j = 0; j < 8; ++j) {
                const float g0 = pre[j] + pin[j] + G0[j], g1 = pre[j] + pin[j] + G1[j];
                const float d0 = fminf(fmaxf(g0 - gref[j], -60.f), 60.f), d1 = fminf(fmaxf(g1 - gref[j], -60.f), 60.f);
                qt[0][j] = qf[0][j] * fexp(d0); kt[0][j] = kf[0][j] * fexp(-d0); qt[1][j] = qf[1][j] * fexp(d1); kt[1][j] = kf[1][j] * fexp(-d1);
            }
#pragma unroll
            for (int rr = 0; rr < 2; ++rr) {
                u32x4 qo, ko; qo.x = pk2(qt[rr][0], qt[rr][1]); qo.y = pk2(qt[rr][2], qt[rr][3]); qo.z = pk2(qt[rr][4], qt[rr][5]); qo.w = pk2(qt[rr][6], qt[rr][7]);
                ko.x = pk2(kt[rr][0], kt[rr][1]); ko.y = pk2(kt[rr][2], kt[rr][3]); ko.z = pk2(kt[rr][4], kt[rr][5]); ko.w = pk2(kt[rr][6], kt[rr][7]);
                *(LAS u32x4*)(lds + L_Q + (2 * rg + rr) * 272 + cgp * 16) = qo; *(LAS u32x4*)(lds + L_K + (2 * rg + rr) * 272 + cgp * 16) = ko;
            }
#pragma unroll
            for (int j = 0; j < 8; ++j) {
                *(LAS unsigned*)(lds + L_KT + (8 * cgp + j) * 144 + rg * 4) = pk2(kt[0][j], kt[1][j]);
                const unsigned v0 = (j & 1) ? (vb[0][j >> 1] >> 16) : (vb[0][j >> 1] & 0xffffu), v1 = (j & 1) ? (vb[1][j >> 1] >> 16) : (vb[1][j >> 1] & 0xffffu);
                *(LAS unsigned*)(lds + L_VT + (8 * cgp + j) * 144 + rg * 4) = v0 | (v1 << 16);
            }
            if (rg == 0) {
#pragma unroll
                for (int j = 0; j < 8; ++j) { LAS float* vp = (LAS float*)(lds + L_VEC) + 8 * cgp + j;
                    vp[0] = fexp(fmaxf(gref[j], -80.f)); vp[128] = fexp(fmaxf(glast[j], -80.f)); vp[256] = fexp(fmaxf(glast[j] - gref[j], -80.f)); }
            }
        }
        __syncthreads();
        if (c + 1 < 32) HG_LOAD(c + 1);
        {
            const f32x4 em = *(const LAS f32x4*)(lds + L_VEC + (16 * w + 4 * fq) * 4);
#pragma unroll
            for (int j = 0; j < 8; ++j) { const f32x4 v = S[j] * em; u32x2 o; o.x = pk2(v[0], v[1]); o.y = pk2(v[2], v[3]);
                *(LAS u32x2*)(lds + L_ST + (16 * j + fr) * 272 + (16 * w + 4 * fq) * 2) = o; }
#pragma unroll
            for (int x = 0; x < 2; ++x) {
                const int lin = 2 * w + x, ti = lin >> 2, si = lin & 3;
                f32x4 acc = (f32x4){0.f, 0.f, 0.f, 0.f};
#pragma unroll
                for (int ks = 0; ks < 4; ++ks) { const bf16x8 a = *(const LAS bf16x8*)(lds + L_K + (16 * si + fr) * 272 + ks * 64 + fq * 16), bq = *(const LAS bf16x8*)(lds + L_Q + (16 * ti + fr) * 272 + ks * 64 + fq * 16);
                    acc = MFMA16(a, bq, acc); }
                const int t = 16 * ti + fr, s0 = 16 * si + 4 * fq;
                float p[4];
#pragma unroll
                for (int i = 0; i < 4; ++i) p[i] = (s0 + i <= t) ? acc[i] : 0.f;
                u32x2 o; o.x = pk2(p[0], p[1]); o.y = pk2(p[2], p[3]);
                *(LAS u32x2*)(lds + L_P + t * 144 + s0 * 2) = o;
            }
        }
        __syncthreads();
        const int ti = w >> 1, eh = w & 1;
        f32x4 o[4]; float ssq = 0.f;
        {
            bf16x8 bq[4], bp[2];
#pragma unroll
            for (int ks = 0; ks < 4; ++ks) bq[ks] = *(const LAS bf16x8*)(lds + L_Q + (16 * ti + fr) * 272 + ks * 64 + fq * 16);
#pragma unroll
            for (int ks = 0; ks < 2; ++ks) bp[ks] = *(const LAS bf16x8*)(lds + L_P + (16 * ti + fr) * 144 + ks * 64 + fq * 16);
#pragma unroll
            for (int jj = 0; jj < 4; ++jj) { const int ej = 4 * eh + jj; f32x4 acc = (f32x4){0.f, 0.f, 0.f, 0.f};
#pragma unroll
                for (int ks = 0; ks < 4; ++ks) { const bf16x8 a = *(const LAS bf16x8*)(lds + L_ST + (16 * ej + fr) * 272 + ks * 64 + fq * 16); acc = MFMA16(a, bq[ks], acc); }
#pragma unroll
                for (int ks = 0; ks < 2; ++ks) { const bf16x8 a = *(const LAS bf16x8*)(lds + L_VT + (16 * ej + fr) * 144 + ks * 64 + fq * 16); acc = MFMA16(a, bp[ks], acc); }
                o[jj] = acc; ssq += (acc[0] * acc[0] + acc[1] * acc[1]) + (acc[2] * acc[2] + acc[3] * acc[3]); }
            ssq += __shfl_xor(ssq, 16); ssq += __shfl_xor(ssq, 32);
            if (fq == 0) *(LAS float*)(lds + L_SSX + ((16 * ti + fr) * 2 + eh) * 4) = ssq;
        }
        const size_t orow = (rowb + 64 * c + 16 * ti + fr) * 512 + h * 128 + 64 * eh + 4 * fq;
        u32x2 sgv[4];
#pragma unroll
        for (int jj = 0; jj < 4; ++jj) sgv[jj] = *(const u32x2*)(sg + orow + 16 * jj);
        {
            const f32x4 aL = *(const LAS f32x4*)(lds + L_VEC + (128 + 16 * w + 4 * fq) * 4), cf = *(const LAS f32x4*)(lds + L_VEC + (256 + 16 * w + 4 * fq) * 4);
            bf16x8 ak[2];
#pragma unroll
            for (int ks = 0; ks < 2; ++ks) ak[ks] = *(const LAS bf16x8*)(lds + L_KT + (16 * w + fr) * 144 + ks * 64 + fq * 16);
#pragma unroll
            for (int j = 0; j < 8; ++j) { f32x4 tmp = (f32x4){0.f, 0.f, 0.f, 0.f};
#pragma unroll
                for (int ks = 0; ks < 2; ++ks) { const bf16x8 bv = *(const LAS bf16x8*)(lds + L_VT + (16 * j + fr) * 144 + ks * 64 + fq * 16); tmp = MFMA16(ak[ks], bv, tmp); }
                S[j] = aL * S[j] + cf * tmp; }
        }
        __syncthreads();
        {
            const float tot = *(const LAS float*)(lds + L_SSX + ((16 * ti + fr) * 2) * 4) + *(const LAS float*)(lds + L_SSX + ((16 * ti + fr) * 2 + 1) * 4);
            const float rn = __builtin_amdgcn_rsqf(tot * (1.f / 128.f) + EPS);
#pragma unroll
            for (int jj = 0; jj < 4; ++jj) { const f32x4 hg = *(const f32x4*)(hgain + 64 * eh + 16 * jj + 4 * fq);
                u32x2 ov; ov.x = pk2(o[jj][0] * rn * hg[0] * bflo(sgv[jj].x), o[jj][1] * rn * hg[1] * bfhi(sgv[jj].x)); ov.y = pk2(o[jj][2] * rn * hg[2] * bflo(sgv[jj].y), o[jj][3] * rn * hg[3] * bfhi(sgv[jj].y));
                *(u32x2*)(ohg + orow + 16 * jj) = ov; }
        }
    }
#undef HG_LOAD
}

__device__ __forceinline__ void attn_units(LAS unsigned char* lds, int first, int stride, const bf16* aq, const bf16* ak, const bf16* av, const float* sinks, bf16* oat, int tid) {
    const int lane = tid & 63, w = __builtin_amdgcn_readfirstlane(tid >> 6), fr = lane & 15, fq = lane >> 4;
    constexpr int L_AK = 0, L_AVT = 36864;
    for (int unit = first; unit < 1024; unit += stride) {
        const int nb = unit & 15, hq = (unit >> 4) & 7, b = unit >> 7, kvh = hq >> 2, t0 = nb * 128;
        const size_t rowb = (size_t)b * SEQ;
#pragma unroll
        for (int i = 0; i < 4; ++i) {
            const int p = tid + 512 * i, key = p >> 3, dc = p & 7, kpos = t0 - 128 + key;
            u32x4 kx = (u32x4){0u, 0u, 0u, 0u}, vx = kx;
            if (kpos >= 0) { const size_t off = (rowb + kpos) * 128 + kvh * 64 + dc * 8; kx = *(const u32x4*)(ak + off); vx = *(const u32x4*)(av + off); }
            *(LAS u32x4*)(lds + L_AK + key * 144 + dc * 16) = kx;
            const unsigned vw[4] = {vx.x, vx.y, vx.z, vx.w};
#pragma unroll
            for (int j = 0; j < 8; ++j) *(LAS unsigned short*)(lds + L_AVT + (dc * 8 + j) * 528 + key * 2) = (unsigned short)((j & 1) ? (vw[j >> 1] >> 16) : (vw[j >> 1] & 0xffffu));
        }
        const int q = 16 * w + fr;
        bf16x8 qf[2];
#pragma unroll
        for (int ks = 0; ks < 2; ++ks) qf[ks] = *(const bf16x8*)(aq + (rowb + t0 + q) * 512 + hq * 64 + ks * 32 + 8 * fq);
        __syncthreads();
        f32x4 sc[9];
#pragma unroll
        for (int jj = 0; jj < 9; ++jj) { const int j = w + jj; f32x4 acc = (f32x4){0.f, 0.f, 0.f, 0.f};
#pragma unroll
            for (int ks = 0; ks < 2; ++ks) { const bf16x8 a = *(const LAS bf16x8*)(lds + L_AK + (16 * j + fr) * 144 + ks * 64 + fq * 16); acc = MFMA16(a, qf[ks], acc); }
            sc[jj] = acc; }
        const float slope = __builtin_amdgcn_exp2f(-(float)(hq + 1)), sink = sinks[hq];
        float mx = sink;
#pragma unroll
        for (int jj = 0; jj < 9; ++jj)
#pragma unroll
            for (int i = 0; i < 4; ++i) { const int key = 16 * (w + jj) + 4 * fq + i, dist = q + 128 - key; const bool valid = dist >= 0 && dist < 128 && (t0 - 128 + key) >= 0;
                const float v = valid ? sc[jj][i] - slope * (float)dist : -INFINITY; sc[jj][i] = v; mx = fmaxf(mx, v); }
        mx = fmaxf(mx, __shfl_xor(mx, 16)); mx = fmaxf(mx, __shfl_xor(mx, 32));
        float l = 0.f;
#pragma unroll
        for (int jj = 0; jj < 9; ++jj)
#pragma unroll
            for (int i = 0; i < 4; ++i) { const float p = fexp(sc[jj][i] - mx); sc[jj][i] = p; l += p; }
        l += __shfl_xor(l, 16); l += __shfl_xor(l, 32);
        l += fexp(sink - mx);
        const float rl = __builtin_amdgcn_rcpf(l);
        bf16x8 pb[5];
#pragma unroll
        for (int J = 0; J < 5; ++J) { u32x4 t; t.x = pk2(sc[2 * J][0], sc[2 * J][1]); t.y = pk2(sc[2 * J][2], sc[2 * J][3]);
            if (2 * J + 1 < 9) { t.z = pk2(sc[(2 * J + 1) % 9][0], sc[(2 * J + 1) % 9][1]); t.w = pk2(sc[(2 * J + 1) % 9][2], sc[(2 * J + 1) % 9][3]); } else { t.z = 0u; t.w = 0u; }
            pb[J] = __builtin_bit_cast(bf16x8, t); }
#pragma unroll
        for (int dt = 0; dt < 4; ++dt) { f32x4 acc = (f32x4){0.f, 0.f, 0.f, 0.f};
#pragma unroll
            for (int J = 0; J < 5; ++J) { const int j0 = w + 2 * J, j1 = (j0 + 1 > 15) ? 15 : j0 + 1;
                const u32x2 lo = *(const LAS u32x2*)(lds + L_AVT + (16 * dt + fr) * 528 + (16 * j0 + 4 * fq) * 2), hi = *(const LAS u32x2*)(lds + L_AVT + (16 * dt + fr) * 528 + (16 * j1 + 4 * fq) * 2);
                u32x4 t; t.x = lo.x; t.y = lo.y; t.z = hi.x; t.w = hi.y;
                acc = MFMA16(__builtin_bit_cast(bf16x8, t), pb[J], acc); }
            u32x2 ov; ov.x = pk2(acc[0] * rl, acc[1] * rl); ov.y = pk2(acc[2] * rl, acc[3] * rl);
            *(u32x2*)(oat + (rowb + t0 + q) * 512 + hq * 64 + 16 * dt + 4 * fq) = ov; }
        __syncthreads();
    }
}

#define RLX_AGENT __ATOMIC_RELAXED, __HIP_MEMORY_SCOPE_AGENT
#define XB_TMO      128
#define XB_XCNT(j)  (256  + 64 * (j))
#define XB_XSUB(j)  (1280 + 64 * (j))
#define XB_XGEN(j)  (2304 + 64 * (j))
#define XB_TOP      3328
#define XB_TOPGEN   3392
#define XCD_BAR_WORDS 3456
#define XB_SPIN_CAP (1u << 18)

__device__ __forceinline__ unsigned xb_ld(unsigned* p)              { return __hip_atomic_load(p, __ATOMIC_RELAXED, __HIP_MEMORY_SCOPE_AGENT); }
__device__ __forceinline__ unsigned xb_add(unsigned* p, unsigned v) { return __hip_atomic_fetch_add(p, v, __ATOMIC_RELAXED, __HIP_MEMORY_SCOPE_AGENT); }
__device__ __forceinline__ unsigned xb_xcc_id() { return (unsigned)__builtin_amdgcn_s_getreg((3 << 11) | 20) & 0xFu; }
#define XB_SPIN(cond, bar) do { unsigned _sp = 0; while (cond) { __builtin_amdgcn_s_sleep(1); \
    if ((++_sp & 255u) == 0u) { if (xb_ld(&(bar)[XB_TMO])) break; if (_sp > XB_SPIN_CAP) { atomicAdd(&(bar)[XB_TMO], 1u); break; } } } } while (0)

struct XcdBarrier {
    unsigned* bar; unsigned x;
    volatile LAS unsigned* st;
};

__device__ __forceinline__ XcdBarrier xcd_barrier_post(unsigned* bar, volatile LAS unsigned* st) {
    XcdBarrier b; b.bar = bar; b.x = xb_xcc_id(); b.st = st;
    if (threadIdx.x == 0) (void)xb_add(&bar[XB_XCNT(b.x)], 1u);
    return b;
}
__device__ __forceinline__ void xcd_barrier_complete(unsigned* bar, unsigned x, unsigned& nloc, unsigned& nx) {
    const unsigned G = gridDim.x * gridDim.y * gridDim.z;
    unsigned sum, cnt, mine, sp = 0u;
    for (;;) {
        sum = 0u; cnt = 0u; mine = 0u;
#pragma unroll
        for (unsigned j = 0; j < 16; ++j) { const unsigned c = xb_ld(&bar[XB_XCNT(j)]); sum += c; cnt += (c > 0u) ? 1u : 0u; mine = (j == x) ? c : mine; }
        if (sum == G) break;
        __builtin_amdgcn_s_sleep(1);
        if ((++sp & 255u) == 0u) { if (xb_ld(&bar[XB_TMO])) break; if (sp > XB_SPIN_CAP) { atomicAdd(&bar[XB_TMO], 1u); break; } }
    }
    nloc = mine > 0u ? mine : 1u; nx = cnt > 0u ? cnt : 1u;
}

__device__ __forceinline__ void xcd_barrier(const XcdBarrier& b) {
    asm volatile("s_waitcnt vmcnt(0)" ::: "memory");
    __syncthreads();
    if (threadIdx.x == 0) {
        unsigned* bar = b.bar;
        __builtin_amdgcn_s_waitcnt(0);
        unsigned nloc = b.st[0], nx = b.st[1];
        if (nloc == 0u) { xcd_barrier_complete(bar, b.x, nloc, nx); b.st[0] = nloc; b.st[1] = nx; }
        const unsigned old = xb_add(&bar[XB_XSUB(b.x)], 1u);
        const unsigned gen = old / nloc;
        if (old + 1u == (gen + 1u) * nloc) {
            __builtin_amdgcn_fence(__ATOMIC_RELEASE, "agent");
            asm volatile("s_waitcnt vmcnt(0)" ::: "memory");
            const unsigned og = xb_add(&bar[XB_TOP], 1u);
            const unsigned tg = og / nx;
            if (og + 1u == (tg + 1u) * nx) xb_add(&bar[XB_TOPGEN], 1u);
            else XB_SPIN(xb_ld(&bar[XB_TOPGEN]) == tg, bar);
            __builtin_amdgcn_fence(__ATOMIC_ACQUIRE, "agent");
            xb_add(&bar[XB_XGEN(b.x)], 1u);
            asm volatile("s_waitcnt vmcnt(0)" ::: "memory");
        } else {
            XB_SPIN(xb_ld(&bar[XB_XGEN(b.x)]) == gen, bar);
            __builtin_amdgcn_fence(__ATOMIC_ACQUIRE, "agent");
            asm volatile("s_waitcnt vmcnt(0)" ::: "memory");
        }
    }
    __syncthreads();
}

struct Args { const float* in[15]; float* out; unsigned char* ws; int ph_lo, ph_hi; };
constexpr int N_PHASES = 23;
#ifndef ONLY_PHASE
#define ONLY_PHASE -1
#endif
#define PH(kk) ((ONLY_PHASE < 0 || ONLY_PHASE == (kk)) && k == (kk))
__global__ void __launch_bounds__(NWAVES * 64, 2) mega_fwd(Args args) {
    extern __shared__ __attribute__((aligned(16))) unsigned char lds_raw[];
    LAS unsigned char* lds = (LAS unsigned char*)lds_raw;
    const int G = gridDim.x, bx = blockIdx.x;
    unsigned char* ws = args.ws;
    float* xs = args.out;
    volatile LAS unsigned* MISC = (volatile LAS unsigned*)(lds + RING_BYTES);
    if (threadIdx.x < 64) MISC[threadIdx.x] = 0u;
    __syncthreads();
    XcdBarrier bar = xcd_barrier_post((unsigned*)ws + 1024, MISC + 8);
    if (args.ph_hi > 1000) cg::this_grid().sync();
#define GRID_BAR() xcd_barrier(bar)
#pragma nounroll
    for (int ph = args.ph_lo; ph < args.ph_hi; ++ph) {
        const int l = ph / 11, k = ph - 11 * l;
#ifdef DUP_MASK
        const int nrep = 1 + (((DUP_MASK >> k) & 1) && (k != 0 || l == 0));
        for (int rep = 0; rep < nrep; ++rep) {
        if (rep) GRID_BAR();
#endif
        int tid = threadIdx.x; asm volatile("" : "+v"(tid));
        const int lane = tid & 63, wave = __builtin_amdgcn_readfirstlane(tid >> 6);
        const int gw = bx * NWAVES + wave, ngw = G * NWAVES;
        const float* gains = args.in[1];
        const float* gn = gains + (size_t)(l < 2 ? l : 1) * 6 * DM;
        bf16* HB = (bf16*)(ws + WS_HB); bf16* ACT = (bf16*)(ws + WS_ACT); float* Y = (float*)(ws + WS_Y); float* SS = (float*)(ws + WS_SS); float* Z = (float*)(ws + WS_Z);
        if (PH(0)) {
            if (l < 2) {
                Inputs I; I.x = args.in[0]; I.gains = args.in[1]; I.g1 = args.in[2]; I.u1 = args.in[3]; I.d1 = args.in[4]; I.win = args.in[5]; I.lbraw = args.in[6]; I.hgain = args.in[7]; I.sinks = args.in[8];
                I.wba = args.in[9]; I.wbb = args.in[10]; I.wout = args.in[11]; I.g2 = args.in[12]; I.u2 = args.in[13]; I.d2 = args.in[14];
                convert_layer(I, l, ws, lds, gw, ngw, wave, lane);
            }
            if (l == 0) row_phase(args.in[0], nullptr, nullptr, nullptr, nullptr, 0.f, gn, HB, gw, ngw, lane);
            else row_phase(xs, xs, Y, SS, gains + (size_t)(l - 1) * 6 * DM + 5 * DM, 0.5f, gn, l < 2 ? HB : nullptr, gw, ngw, lane);
            __syncthreads();
        }
        if (PH(1) || PH(9)) { pg8::Gemm g{HB, (const bf16*)(ws + (k == 1 ? WS_WGU1 : WS_WGU2)), NT, 2 * DFF, DM}; pg8::StaticOrder S; S.init(NT, 2 * DFF, G, bx); pg8::EpiGU E{ACT, DFF};
            pg8::gemm_phase<pg8::EpiGU, pg8::StaticOrder, true, true>(lds, g, S, E); }
        if (PH(2) || PH(10)) { pg8::Gemm g{ACT, (const bf16*)(ws + (k == 2 ? WS_WD1 : WS_WD2)), NT, DM, DFF}; pg8::StaticOrder S; S.init(NT, DM, G, bx); pg8::EpiF32SS E{Y, SS};
            pg8::gemm_phase<pg8::EpiF32SS, pg8::StaticOrder, true, true>(lds, g, S, E); }
        if (PH(3)) row_phase(l == 0 ? args.in[0] : xs, xs, Y, SS, gn + 1 * DM, 0.5f, gn + 2 * DM, HB, gw, ngw, lane);
        if (PH(4)) { pg8::Gemm g{HB, (const bf16*)(ws + WS_WIN), NT, DIN, DM}; pg8::StaticOrder S; S.init(NT, DIN, G, bx);
            pg8::EpiProj E{(bf16*)(ws + WS_QS), (bf16*)(ws + WS_KK), (bf16*)(ws + WS_VI), (bf16*)(ws + WS_SG), (bf16*)(ws + WS_AQ), (bf16*)(ws + WS_AK), (bf16*)(ws + WS_AV), (bf16*)(ws + WS_GA), (bf16*)(ws + WS_GB),
                           (float*)(ws + WS_LOGF), args.in[6], l};
            pg8::gemm_phase<pg8::EpiProj, pg8::StaticOrder, true, true>(lds, g, S, E); }
        if (PH(5)) {
#ifndef SKIP_HGRN
            if (bx < 32) hgrn_seq(lds, bx, (const bf16*)(ws + WS_QS), (const float*)(ws + WS_LOGF), (const bf16*)(ws + WS_KK), (const bf16*)(ws + WS_VI), (const bf16*)(ws + WS_SG), args.in[7] + l * 128, (bf16*)(ws + WS_OHG), tid);
#endif
#ifndef SKIP_ATTN
            if (bx >= 32) attn_units(lds, bx - 32, G - 32, (const bf16*)(ws + WS_AQ), (const bf16*)(ws + WS_AK), (const bf16*)(ws + WS_AV), args.in[8] + l * 8, (bf16*)(ws + WS_OAT), tid);
#endif
            __syncthreads();
        }
        if (PH(6)) {
            { pg8::Gemm g{(const bf16*)(ws + WS_OHG), (const bf16*)(ws + WS_WBA), NT, DM, 512}; pg8::StaticOrder S; S.init(NT, DM, G, bx); pg8::EpiMix<0> E{(const bf16*)(ws + WS_GA), (float*)(ws + WS_M1), nullptr};
              pg8::gemm_phase<pg8::EpiMix<0>, pg8::StaticOrder, true, true>(lds, g, S, E); }
            { pg8::Gemm g{(const bf16*)(ws + WS_OAT), (const bf16*)(ws + WS_WBB), NT, DM, 512}; pg8::StaticOrder S; S.init(NT, DM, G, bx); pg8::EpiMix<1> E{(const bf16*)(ws + WS_GB), (float*)(ws + WS_M1), (bf16*)(ws + WS_MIXED)};
              pg8::gemm_phase<pg8::EpiMix<1>, pg8::StaticOrder, true, true>(lds, g, S, E); }
        }
        if (PH(7)) { pg8::Gemm g{(const bf16*)(ws + WS_MIXED), (const bf16*)(ws + WS_WOUT), NT, DM, DM}; pg8::StaticOrder S; S.init(NT, DM, G, bx); pg8::EpiF32SS E{Z, SS};
            pg8::gemm_phase<pg8::EpiF32SS, pg8::StaticOrder, true, true>(lds, g, S, E); }
        if (PH(8)) row_phase(xs, xs, Z, SS, gn + 3 * DM, 1.0f, gn + 4 * DM, HB, gw, ngw, lane);
#ifdef DUP_MASK
        }
#endif
        if (ph + 1 < args.ph_hi) GRID_BAR();
#ifdef DUP_SYNC
        if (ph + 1 < args.ph_hi) GRID_BAR();
#endif
    }
}
#undef PH

#ifndef MK_ONE_LAUNCH
#define MK_ONE_LAUNCH 1
#endif
extern "C" void kernel_launch(void* const* d_in, const int* in_sizes, int n_in, void* d_out, int out_size, void* d_ws, size_t ws_size, hipStream_t stream) {
    static int grid = 0;
    if (grid == 0) {
        if (n_in != 15 || out_size != NT * DM || ws_size < WS_END) { fprintf(stderr, "kernel_launch: unexpected shapes (n_in %d out %d ws %zu)\n", n_in, out_size, ws_size); grid = -1; return; }
        int dev = 0, cus = 0, per_cu = 0;
        hipGetDevice(&dev); hipDeviceGetAttribute(&cus, hipDeviceAttributeMultiprocessorCount, dev);
        if (hipFuncSetAttribute((const void*)mega_fwd, hipFuncAttributeMaxDynamicSharedMemorySize, LDS_BYTES) != hipSuccess) { fprintf(stderr, "kernel_launch: hipFuncSetAttribute failed\n"); grid = -1; return; }
        if (hipOccupancyMaxActiveBlocksPerMultiprocessor(&per_cu, (const void*)mega_fwd, NWAVES * 64, LDS_BYTES) != hipSuccess || per_cu < 1) { fprintf(stderr, "kernel_launch: occupancy query says %d\n", per_cu); per_cu = 1; }
        (void)hipGetLastError();
        grid = cus;
        fprintf(stderr, "kernel_launch: grid %d (per_cu %d)\n", grid, per_cu);
    }
    if (grid < 0) return;
    if (hipMemsetAsync(d_ws, 0, 32768, stream) != hipSuccess) { fprintf(stderr, "kernel_launch: memset failed\n"); return; }
    Args a{};
    for (int i = 0; i < 15; ++i) a.in[i] = (const float*)d_in[i];
    a.out = (float*)d_out; a.ws = (unsigned char*)d_ws;
#if MK_ONE_LAUNCH
    a.ph_lo = 0; a.ph_hi = N_PHASES;
    void* kargs[] = {&a};
    hipError_t e = hipLaunchCooperativeKernel((const void*)mega_fwd, dim3(grid), dim3(NWAVES * 64), kargs, LDS_BYTES, stream);
    if (e != hipSuccess) fprintf(stderr, "cooperative launch failed: %s (grid %d)\n", hipGetErrorString(e), grid);
#else
    for (int p = 0; p < N_PHASES; ++p) { a.ph_lo = p; a.ph_hi = p + 1; hipLaunchKernelGGL(mega_fwd, dim3(grid), dim3(NWAVES * 64), LDS_BYTES, stream, a); }
#endif
}
```
